# Optimizing an MI355X kernel written in HIP

```python
import math
import jax, jax.numpy as jnp
from jax import lax
import numpy as np

D_MODEL = 1024
BATCH = 8
SEQ = 2048
DEPTH = 4

N_A = DEPTH // 2
N_B = DEPTH - N_A
PLE_DIM = 256
N_HEADS = 16
HEAD_DIM = 64
ROPE_DIM = 32
QK_DIM = HEAD_DIM + ROPE_DIM
Q_LORA = 384
KV_LORA = 256
MIX_WIDTH = N_HEADS * HEAD_DIM
MLA_IN = Q_LORA + KV_LORA + ROPE_DIM + MIX_WIDTH
SB_IN = 2 * MIX_WIDTH
ROPE_THETA = 10000.0
Q_BLOCK = 128
EPS = 1e-6

kernel_name = "yoco_mla_stickbreaking_hybrid"


def rmsnorm(x, g):
    xf = x.astype(jnp.float32)
    y = xf * lax.rsqrt(jnp.mean(xf * xf, axis=-1, keepdims=True) + EPS)
    return (y * g.astype(jnp.float32)).astype(x.dtype)


def rope(x, pos):
    half = ROPE_DIM // 2
    inv = 1.0 / (ROPE_THETA ** (jnp.arange(half, dtype=jnp.float32) / half))
    ang = pos.astype(jnp.float32)[..., None] * inv
    cos = jnp.cos(ang)[:, :, None, :]
    sin = jnp.sin(ang)[:, :, None, :]
    x1 = x[..., :half].astype(jnp.float32)
    x2 = x[..., half:].astype(jnp.float32)
    out = jnp.concatenate([x1 * cos - x2 * sin, x2 * cos + x1 * sin], axis=-1)
    return out.astype(x.dtype)


def _blocks(q):
    B, H, S, d = q.shape
    nb = S // Q_BLOCK
    return q.reshape(B, H, nb, Q_BLOCK, d).transpose(2, 0, 1, 3, 4), nb


def _unblocks(o):
    nb, B, H, qb, d = o.shape
    return o.transpose(1, 2, 0, 3, 4).reshape(B, H, nb * qb, d)


def causal_softmax_attention(q, k, v):
    S = q.shape[2]
    qb, nb = _blocks(q)
    s_idx = jnp.arange(S)
    scale = QK_DIM ** -0.5

    def one(args):
        qi, bi = args
        t_idx = bi * Q_BLOCK + jnp.arange(Q_BLOCK)
        logits = jnp.einsum('bhqd,bhkd->bhqk', qi, k,
                            preferred_element_type=jnp.float32) * scale
        mask = s_idx[None, :] <= t_idx[:, None]
        w = jax.nn.softmax(jnp.where(mask, logits, -jnp.inf), axis=-1)
        return jnp.einsum('bhqk,bhkd->bhqd', w.astype(v.dtype), v)

    return _unblocks(lax.map(one, (qb, jnp.arange(nb))))


def stick_breaking_attention(q, k, v):
    S = q.shape[2]
    qb, nb = _blocks(q)
    s_idx = jnp.arange(S)
    scale = HEAD_DIM ** -0.5

    def one(args):
        qi, bi = args
        t_idx = bi * Q_BLOCK + jnp.arange(Q_BLOCK)
        z = jnp.einsum('bhqd,bhkd->bhqk', qi, k,
                       preferred_element_type=jnp.float32) * scale
        mask = s_idx[None, :] < t_idx[:, None]
        log_beta = jax.nn.log_sigmoid(z)
        log_one_minus = jnp.where(mask, jax.nn.log_sigmoid(-z), 0.0)
        tail = lax.cumsum(log_one_minus, axis=log_one_minus.ndim - 1,
                          reverse=True) - log_one_minus
        a = jnp.where(mask, jnp.exp(log_beta + tail), 0.0)
        return jnp.einsum('bhqk,bhkd->bhqd', a.astype(v.dtype), v)

    return _unblocks(lax.map(one, (qb, jnp.arange(nb))))


def mla_layer(x, positions, ln_g, w_in, q_norm_g, kv_norm_g, w_q_up, w_kv_up,
              q_head_g, k_head_g, w_out):
    B, S, _ = x.shape
    h = rmsnorm(x, ln_g)
    proj = h @ w_in
    c_q, c_kv, k_rope, gate = jnp.split(
        proj, [Q_LORA, Q_LORA + KV_LORA, Q_LORA + KV_LORA + ROPE_DIM], axis=-1)
    q = (rmsnorm(c_q, q_norm_g) @ w_q_up).reshape(B, S, N_HEADS, QK_DIM)
    kv = (rmsnorm(c_kv, kv_norm_g) @ w_kv_up).reshape(B, S, N_HEADS, 2 * HEAD_DIM)
    k_nope, v = kv[..., :HEAD_DIM], kv[..., HEAD_DIM:]
    k = jnp.concatenate(
        [k_nope, jnp.broadcast_to(k_rope[:, :, None, :], (B, S, N_HEADS, ROPE_DIM))], axis=-1)
    q = rmsnorm(q, q_head_g)
    k = rmsnorm(k, k_head_g)
    q = jnp.concatenate([q[..., :HEAD_DIM], rope(q[..., HEAD_DIM:], positions)], axis=-1)
    k = jnp.concatenate([k[..., :HEAD_DIM], rope(k[..., HEAD_DIM:], positions)], axis=-1)
    o = causal_softmax_attention(q.transpose(0, 2, 1, 3), k.transpose(0, 2, 1, 3),
                                 v.transpose(0, 2, 1, 3))
    o = o.transpose(0, 2, 1, 3).reshape(B, S, MIX_WIDTH) * jax.nn.silu(gate)
    return x + o @ w_out


def sb_layer(x, k_sh, v_sh, ln_g, w_in, w_out):
    B, S, _ = x.shape
    h = rmsnorm(x, ln_g)
    q, gate = jnp.split(h @ w_in, [MIX_WIDTH], axis=-1)
    q = q.reshape(B, S, N_HEADS, HEAD_DIM).transpose(0, 2, 1, 3)
    o = stick_breaking_attention(q, k_sh, v_sh)
    o = o.transpose(0, 2, 1, 3).reshape(B, S, MIX_WIDTH) * jax.nn.silu(gate)
    return x + o @ w_out


def setup_inputs(seed: int = 0) -> dict:
    key = jax.random.key(seed)
    ks = jax.random.split(key, 24)

    def w(k, shape, fan_in):
        return jax.random.normal(k, shape, jnp.float32) * (fan_in ** -0.5)

    def gain(k, shape):
        return 1.0 + 0.02 * jax.random.normal(k, shape, jnp.float32)

    x = jax.random.normal(ks[0], (BATCH, SEQ, D_MODEL), jnp.float32)
    p = jax.random.normal(ks[1], (DEPTH, BATCH, SEQ, PLE_DIM), jnp.float32)
    offs = jax.random.randint(ks[2], (BATCH, 1), 0, 1024, dtype=jnp.int32)
    positions = offs + jnp.arange(SEQ, dtype=jnp.int32)[None, :]
    return {
        "x": x,
        "p": p,
        "positions": positions,
        "mla_ln_g": gain(ks[3], (N_A, D_MODEL)),
        "mla_w_in": w(ks[4], (N_A, D_MODEL, MLA_IN), D_MODEL),
        "mla_q_norm_g": gain(ks[5], (N_A, Q_LORA)),
        "mla_kv_norm_g": gain(ks[6], (N_A, KV_LORA)),
        "mla_w_q_up": w(ks[7], (N_A, Q_LORA, N_HEADS * QK_DIM), Q_LORA),
        "mla_w_kv_up": w(ks[8], (N_A, KV_LORA, N_HEADS * 2 * HEAD_DIM), KV_LORA),
        "mla_q_head_g": gain(ks[9], (N_A, QK_DIM)),
        "mla_k_head_g": gain(ks[10], (N_A, QK_DIM)),
        "mla_w_out": w(ks[11], (N_A, MIX_WIDTH, D_MODEL), MIX_WIDTH),
        "kv_ln_g": gain(ks[12], (D_MODEL,)),
        "w_kv_shared": w(ks[13], (D_MODEL, 2 * MIX_WIDTH), D_MODEL),
        "sb_ln_g": gain(ks[14], (N_B, D_MODEL)),
        "sb_w_in": w(ks[15], (N_B, D_MODEL, SB_IN), D_MODEL),
        "sb_w_out": w(ks[16], (N_B, MIX_WIDTH, D_MODEL), MIX_WIDTH),
        "ple_w_proj": w(ks[17], (DEPTH, PLE_DIM, D_MODEL), PLE_DIM),
        "ple_w_gate": w(ks[18], (DEPTH, D_MODEL, D_MODEL), D_MODEL),
    }


def reference(x, p, positions, mla_ln_g, mla_w_in, mla_q_norm_g, mla_kv_norm_g,
              mla_w_q_up, mla_w_kv_up, mla_q_head_g, mla_k_head_g, mla_w_out,
              kv_ln_g, w_kv_shared, sb_ln_g, sb_w_in, sb_w_out,
              ple_w_proj, ple_w_gate):
    B, S, _ = x.shape
    k_sh = v_sh = None
    for i in range(DEPTH):
        if i < N_A:
            x = mla_layer(x, positions, mla_ln_g[i], mla_w_in[i], mla_q_norm_g[i],
                          mla_kv_norm_g[i], mla_w_q_up[i], mla_w_kv_up[i],
                          mla_q_head_g[i], mla_k_head_g[i], mla_w_out[i])
        else:
            j = i - N_A
            x = sb_layer(x, k_sh, v_sh, sb_ln_g[j], sb_w_in[j], sb_w_out[j])
        x = x + jax.nn.sigmoid(x @ ple_w_gate[i]) * (p[i] @ ple_w_proj[i])
        if i == N_A - 1:
            kv = rmsnorm(x, kv_ln_g) @ w_kv_shared
            k_sh = kv[..., :MIX_WIDTH].reshape(B, S, N_HEADS, HEAD_DIM).transpose(0, 2, 1, 3)
            v_sh = kv[..., MIX_WIDTH:].reshape(B, S, N_HEADS, HEAD_DIM).transpose(0, 2, 1, 3)
    return x
```

```cpp
#include <hip/hip_runtime.h>
#include <hip/hip_cooperative_groups.h>
#include <cstdio>
#include <cstdint>
namespace cg = cooperative_groups;

typedef unsigned short u16;
using bf16x8 = __attribute__((ext_vector_type(8))) short;
using f32x16 = __attribute__((ext_vector_type(16))) float;
using f32x4  = __attribute__((ext_vector_type(4))) float;
using u32x4  = __attribute__((ext_vector_type(4))) unsigned;
using u32x2  = __attribute__((ext_vector_type(2))) unsigned;
typedef float f32x2_t __attribute__((ext_vector_type(2)));
typedef __bf16 bf16x2_t __attribute__((ext_vector_type(2)));
#define DI __device__ __forceinline__
#define LAS __attribute__((address_space(3)))

constexpr int T_ = 16384, S_ = 2048;
constexpr float EPS = 1e-6f;
constexpr float LOG2E = 1.4426950408889634f;
constexpr int NTHR = 256;

constexpr size_t WS_BAR  = 0;
constexpr size_t WS_COS  = 16384;
constexpr size_t WS_SIN  = WS_COS + (size_t)T_ * 16 * 4;
constexpr size_t WS_W    = WS_SIN + (size_t)T_ * 16 * 4;
constexpr size_t W_MLA_SZ  = (size_t)1792 * 1024 + 1536 * 384 + 2048 * 256 + 1024 * 1024;
constexpr size_t W_MLA_Q   = (size_t)1792 * 1024;
constexpr size_t W_MLA_KV  = W_MLA_Q + (size_t)1536 * 384;
constexpr size_t W_MLA_OUT = W_MLA_KV + (size_t)2048 * 256;
constexpr size_t W_SB0     = 2 * W_MLA_SZ;
constexpr size_t W_SB0_OUT = W_SB0 + (size_t)4096 * 1024;
constexpr size_t W_SB1     = W_SB0_OUT + (size_t)1024 * 1024;
constexpr size_t W_SB1_OUT = W_SB1 + (size_t)2048 * 1024;
constexpr size_t W_PLE     = W_SB1_OUT + (size_t)1024 * 1024;
constexpr size_t W_PLE_SZ  = (size_t)1024 * 1024 + 1024 * 256;
constexpr size_t W_TOTAL   = W_PLE + 4 * W_PLE_SZ;
constexpr size_t WS_XA    = WS_W + W_TOTAL * 2;
constexpr size_t WS_CQ    = WS_XA + (size_t)T_ * 1024 * 4;
constexpr size_t WS_GATE  = WS_CQ + (size_t)T_ * 640 * 2;
constexpr size_t WS_KROPE = WS_GATE + (size_t)T_ * 1024 * 2;
constexpr size_t WS_KBUF  = WS_KROPE + (size_t)T_ * 32 * 2;
constexpr size_t WS_VT    = WS_KBUF + (size_t)T_ * 16 * 96 * 2;
constexpr size_t WS_END   = WS_VT + (size_t)T_ * 1024 * 2;
static_assert(WS_XA % 256 == 0 && WS_END <= (size_t)256 * 1024 * 1024, "workspace map");

constexpr int GEMM_LDT = 72;
constexpr int GEMM_BUF = 128 * GEMM_LDT;
constexpr int SMEM_MAIN = 4 * GEMM_BUF * 2;
constexpr int SMEM_ROWSS = SMEM_MAIN;
constexpr int SMEM_ST = SMEM_MAIN + 512;
constexpr int SMEM_BYTES = SMEM_ST + 16;
constexpr int CS_LD = 132;

struct Params {
  const float* x; const float* p; const int* pos;
  const float* mla_ln_g; const float* mla_w_in; const float* mla_q_norm_g; const float* mla_kv_norm_g;
  const float* mla_w_q_up; const float* mla_w_kv_up; const float* mla_q_head_g; const float* mla_k_head_g;
  const float* mla_w_out; const float* kv_ln_g; const float* w_kv_shared; const float* sb_ln_g;
  const float* sb_w_in; const float* sb_w_out; const float* ple_w_proj; const float* ple_w_gate;
  float* out; unsigned char* ws;
};

__device__ const float c_inv_freq[16] = {
  1.000000000e+00f, 5.623413324e-01f, 3.162277639e-01f, 1.778279394e-01f, 1.000000015e-01f, 5.623412877e-02f,
  3.162277862e-02f, 1.778279431e-02f, 9.999999776e-03f, 5.623413250e-03f, 3.162277862e-03f, 1.778279431e-03f,
  1.000000047e-03f, 5.623413017e-04f, 3.162277862e-04f, 1.778279402e-04f};

DI unsigned cvtpk(float lo, float hi) { f32x2_t v = {lo, hi}; bf16x2_t b = __builtin_convertvector(v, bf16x2_t); return __builtin_bit_cast(unsigned, b); }
DI float bflo(unsigned u) { return __uint_as_float(u << 16); }
DI float bfhi(unsigned u) { return __uint_as_float(u & 0xffff0000u); }
DI u16 f2bf(float f) { return (u16)(cvtpk(f, 0.f) & 0xffffu); }
DI float fexp2(float x) { return __builtin_amdgcn_exp2f(x); }
DI float flog2(float x) { return __builtin_amdgcn_logf(x); }
DI float frcp(float x) { return __builtin_amdgcn_rcpf(x); }
DI float frsq(float x) { return __builtin_amdgcn_rsqf(x); }
DI int otid() { int t = threadIdx.x; asm volatile("" : "+v"(t)); return t; }
DI int crow(int i, int h) { return (i & 3) + 8 * (i >> 2) + 4 * h; }
DI f32x16 mfma32(bf16x8 a, bf16x8 b, f32x16 c) { return __builtin_amdgcn_mfma_f32_32x32x16_bf16(a, b, c, 0, 0, 0); }
DI float pair_max(float x) { auto rr = __builtin_amdgcn_permlane32_swap(__float_as_uint(x), __float_as_uint(x), false, false); return fmaxf(__uint_as_float(rr[0]), __uint_as_float(rr[1])); }
DI float pair_sum(float x) { auto rr = __builtin_amdgcn_permlane32_swap(__float_as_uint(x), __float_as_uint(x), false, false); return __uint_as_float(rr[0]) + __uint_as_float(rr[1]); }
DI float pair_other(float x, int h) { auto rr = __builtin_amdgcn_permlane32_swap(__float_as_uint(x), __float_as_uint(x), false, false); return h ? __uint_as_float(rr[0]) : __uint_as_float(rr[1]); }
DI float silu_mul(float o, float g) { return o * g * frcp(1.f + fexp2(-g * LOG2E)); }

#define XB_TMO      128
#define XB_XCNT(j)  (256  + 64 * (j))
#define XB_XSUB(j)  (1280 + 64 * (j))
#define XB_XGEN(j)  (2304 + 64 * (j))
#define XB_TOP      3328
#define XB_TOPGEN   3392
#define XCD_BAR_WORDS 3456
#define XB_SPIN_CAP (1u << 20)
DI unsigned xb_ld(unsigned* p)              { return __hip_atomic_load(p, __ATOMIC_RELAXED, __HIP_MEMORY_SCOPE_AGENT); }
DI unsigned xb_add(unsigned* p, unsigned v) { return __hip_atomic_fetch_add(p, v, __ATOMIC_RELAXED, __HIP_MEMORY_SCOPE_AGENT); }
DI unsigned xb_xcc_id() { return (unsigned)__builtin_amdgcn_s_getreg((3 << 11) | 20) & 0xFu; }
#define XB_SPIN(cond, bar) do { unsigned _sp = 0; while (cond) { __builtin_amdgcn_s_sleep(1); \
    if ((++_sp & 255u) == 0u) { if (xb_ld(&(bar)[XB_TMO])) break; if (_sp > XB_SPIN_CAP) { atomicAdd(&(bar)[XB_TMO], 1u); break; } } } } while (0)
struct XcdBarrier { unsigned* bar; unsigned x; volatile LAS unsigned* st; };
DI XcdBarrier xcd_barrier_post(unsigned* bar, volatile LAS unsigned* st) {
  XcdBarrier b; b.bar = bar; b.x = xb_xcc_id(); b.st = st;
  if (threadIdx.x == 0) (void)xb_add(&bar[XB_XCNT(b.x)], 1u);
  return b;
}
DI void xcd_barrier_complete(unsigned* bar, unsigned x, unsigned& nloc, unsigned& nx) {
  const unsigned G = gridDim.x * gridDim.y * gridDim.z;
  unsigned sum, cnt, mine, sp = 0u;
  for (;;) {
    sum = 0u; cnt = 0u; mine = 0u;
#pragma unroll
    for (unsigned j = 0; j < 16; ++j) { const unsigned c = xb_ld(&bar[XB_XCNT(j)]); sum += c; cnt += (c > 0u) ? 1u : 0u; mine = (j == x) ? c : mine; }
    if (sum == G) break;
    __builtin_amdgcn_s_sleep(1);
    if ((++sp & 255u) == 0u) { if (xb_ld(&bar[XB_TMO])) break; if (sp > XB_SPIN_CAP) { atomicAdd(&bar[XB_TMO], 1u); break; } }
  }
  nloc = mine > 0u ? mine : 1u; nx = cnt > 0u ? cnt : 1u;
}
DI void xcd_barrier(const XcdBarrier& b) {
  asm volatile("s_waitcnt vmcnt(0)" ::: "memory");
  __syncthreads();
  if (threadIdx.x == 0) {
    unsigned* bar = b.bar;
    __builtin_amdgcn_s_waitcnt(0);
    unsigned nloc = b.st[0], nx = b.st[1];
    if (nloc == 0u) { xcd_barrier_complete(bar, b.x, nloc, nx); b.st[0] = nloc; b.st[1] = nx; }
    const unsigned old = xb_add(&bar[XB_XSUB(b.x)], 1u);
    const unsigned gen = old / nloc;
    if (old + 1u == (gen + 1u) * nloc) {
      __builtin_amdgcn_fence(__ATOMIC_RELEASE, "agent");
      asm volatile("s_waitcnt vmcnt(0)" ::: "memory");
      const unsigned og = xb_add(&bar[XB_TOP], 1u);
      const unsigned tg = og / nx;
      if (og + 1u == (tg + 1u) * nx) xb_add(&bar[XB_TOPGEN], 1u);
      else XB_SPIN(xb_ld(&bar[XB_TOPGEN]) == tg, bar);
      __builtin_amdgcn_fence(__ATOMIC_ACQUIRE, "agent");
      xb_add(&bar[XB_XGEN(b.x)], 1u);
      asm volatile("s_waitcnt vmcnt(0)" ::: "memory");
    } else {
      XB_SPIN(xb_ld(&bar[XB_XGEN(b.x)]) == gen, bar);
      __builtin_amdgcn_fence(__ATOMIC_ACQUIRE, "agent");
      asm volatile("s_waitcnt vmcnt(0)" ::: "memory");
    }
  }
  __syncthreads();
}

struct Job { const float* src; const float* gain; u16* dst; int K, ldsrc, Ndst, mode, nscale; };
DI Job get_job(const Params& P, int j) {
  u16* W = (u16*)(P.ws + WS_W);
  Job b; b.mode = 0; b.nscale = 0; b.gain = nullptr;
  if (j < 8) {
    const int l = j >> 2, q = j & 3; u16* base = W + l * W_MLA_SZ;
    if (q == 0)      { b.src = P.mla_w_in + (size_t)l * 1024 * 1696; b.gain = P.mla_ln_g + l * 1024; b.dst = base; b.K = 1024; b.ldsrc = 1696; b.Ndst = 1792; b.mode = 1; }
    else if (q == 1) { b.src = P.mla_w_q_up + (size_t)l * 384 * 1536; b.gain = P.mla_q_norm_g + l * 384; b.dst = base + W_MLA_Q; b.K = 384; b.ldsrc = 1536; b.Ndst = 1536; }
    else if (q == 2) { b.src = P.mla_w_kv_up + (size_t)l * 256 * 2048; b.gain = P.mla_kv_norm_g + l * 256; b.dst = base + W_MLA_KV; b.K = 256; b.ldsrc = 2048; b.Ndst = 2048; }
    else             { b.src = P.mla_w_out + (size_t)l * 1024 * 1024; b.dst = base + W_MLA_OUT; b.K = 1024; b.ldsrc = 1024; b.Ndst = 1024; }
  } else if (j == 8)  { b.src = P.sb_w_in; b.gain = P.sb_ln_g; b.dst = W + W_SB0; b.K = 1024; b.ldsrc = 2048; b.Ndst = 2048; b.nscale = 1024; }
  else if (j == 9)    { b.src = P.w_kv_shared; b.gain = P.kv_ln_g; b.dst = W + W_SB0 + (size_t)2048 * 1024; b.K = 1024; b.ldsrc = 2048; b.Ndst = 2048; }
  else if (j == 10)   { b.src = P.sb_w_out; b.dst = W + W_SB0_OUT; b.K = 1024; b.ldsrc = 1024; b.Ndst = 1024; }
  else if (j == 11)   { b.src = P.sb_w_in + (size_t)1024 * 2048; b.gain = P.sb_ln_g + 1024; b.dst = W + W_SB1; b.K = 1024; b.ldsrc = 2048; b.Ndst = 2048; b.nscale = 1024; }
  else if (j == 12)   { b.src = P.sb_w_out + (size_t)1024 * 1024; b.dst = W + W_SB1_OUT; b.K = 1024; b.ldsrc = 1024; b.Ndst = 1024; }
  else {
    const int i = (j - 13) >> 1, q = (j - 13) & 1; u16* base = W + W_PLE + i * W_PLE_SZ;
    if (q == 0) { b.src = P.ple_w_gate + (size_t)i * 1024 * 1024; b.dst = base; b.K = 1024; b.ldsrc = 1024; b.Ndst = 1024; }
    else        { b.src = P.ple_w_proj + (size_t)i * 256 * 1024; b.dst = base + (size_t)1024 * 1024; b.K = 256; b.ldsrc = 1024; b.Ndst = 1024; }
  }
  return b;
}
constexpr int NJOBS = 21;

DI void phase_prep(const Params& P, unsigned char* smem, int v, int G) {
  const int tid = otid();
  {
    float* cosT = (float*)(P.ws + WS_COS); float* sinT = (float*)(P.ws + WS_SIN);
    for (int e = v * NTHR + tid; e < T_ * 16; e += G * NTHR) {
      const int t = e >> 4, i = e & 15;
      const float ang = (float)P.pos[t] * c_inv_freq[i];
      const double rev = (double)ang * 0.15915494309189535;
      const float fr = (float)(rev - __builtin_rint(rev));
      cosT[e] = __builtin_amdgcn_cosf(fr); sinT[e] = __builtin_amdgcn_sinf(fr);
    }
  }
  float* tile = (float*)smem;
  for (int j = 0; j < NJOBS; ++j) {
    const Job jb = get_job(P, j);
    const int nkt = jb.K >> 6, ntiles = (jb.Ndst >> 5) * nkt;
    for (int tIdx = v; tIdx < ntiles; tIdx += G) {
      const int nb = tIdx / nkt, kb = tIdx - nb * nkt;
      const int n0 = nb * 32, k0 = kb * 64;
      int sc; bool zero = false;
      if (jb.mode == 1) { if (n0 < 640) sc = n0; else if (n0 < 1664) sc = n0 + 32; else if (n0 < 1696) sc = n0 - 1024; else { sc = 0; zero = true; } }
      else sc = n0;
      const float colscale = (n0 < jb.nscale) ? 0.125f * LOG2E : 1.f;
      __syncthreads();
#pragma unroll
      for (int jj = 0; jj < 8; ++jj) {
        const int kk = (tid >> 5) + 8 * jj, nn = tid & 31;
        float val = 0.f;
        if (!zero) { val = jb.src[(size_t)(k0 + kk) * jb.ldsrc + sc + nn]; if (jb.gain) val *= jb.gain[k0 + kk]; val *= colscale; }
        tile[kk * 33 + nn] = val;
      }
      __syncthreads();
      {
        const int nn = tid >> 3, kq = tid & 7;
        u32x4 o;
        o[0] = cvtpk(tile[(kq * 8 + 0) * 33 + nn], tile[(kq * 8 + 1) * 33 + nn]);
        o[1] = cvtpk(tile[(kq * 8 + 2) * 33 + nn], tile[(kq * 8 + 3) * 33 + nn]);
        o[2] = cvtpk(tile[(kq * 8 + 4) * 33 + nn], tile[(kq * 8 + 5) * 33 + nn]);
        o[3] = cvtpk(tile[(kq * 8 + 6) * 33 + nn], tile[(kq * 8 + 7) * 33 + nn]);
        *(u32x4*)(jb.dst + (size_t)(n0 + nn) * jb.K + k0 + kq * 8) = o;
      }
    }
  }
}

template <bool AF32, bool SUMSQ>
DI void gemm_main(const void* __restrict__ Ap, int lda, const u16* __restrict__ Bp, int ldb, int K,
                  f32x16 (&acc)[2][2], u16* smem, float* rowss, float invK) {
  const int tid = otid(), lane = tid & 63, w = tid >> 6, wm = w >> 1, wn = w & 1, r = lane & 31, h = lane >> 5;
  u16* As = smem; u16* Bs = smem + 2 * GEMM_BUF;
  const int nk = K >> 6;
  f32x4 af[8]; u32x4 ab[4]; u32x4 bb[4];
  float ss[8];
#pragma unroll
  for (int j = 0; j < 8; ++j) ss[j] = 0.f;
  const float* a_f = (const float*)Ap + (size_t)(tid >> 4) * lda + (tid & 15) * 4;
  const u16*   a_b = (const u16*)Ap + (size_t)(tid >> 3) * lda + (tid & 7) * 8;
  const u16*   b_b = Bp + (size_t)(tid >> 3) * ldb + (tid & 7) * 8;

#define G_LOAD(kt) do { \
    if constexpr (AF32) { _Pragma("unroll") for (int j = 0; j < 8; ++j) af[j] = *(const f32x4*)(a_f + (size_t)j * 16 * lda + (kt) * 64); } \
    else { _Pragma("unroll") for (int j = 0; j < 4; ++j) ab[j] = *(const u32x4*)(a_b + (size_t)j * 32 * lda + (kt) * 64); } \
    _Pragma("unroll") for (int j = 0; j < 4; ++j) bb[j] = *(const u32x4*)(b_b + (size_t)j * 32 * ldb + (kt) * 64); } while (0)
#define S_STORE(buf) do { \
    if constexpr (AF32) { _Pragma("unroll") for (int j = 0; j < 8; ++j) { \
        u32x2 pk; pk[0] = cvtpk(af[j][0], af[j][1]); pk[1] = cvtpk(af[j][2], af[j][3]); \
        *(u32x2*)(As + (buf) * GEMM_BUF + ((tid >> 4) + 16 * j) * GEMM_LDT + (tid & 15) * 4) = pk; \
        if constexpr (SUMSQ) ss[j] += af[j][0] * af[j][0] + af[j][1] * af[j][1] + af[j][2] * af[j][2] + af[j][3] * af[j][3]; } } \
    else { _Pragma("unroll") for (int j = 0; j < 4; ++j) { \
        *(u32x4*)(As + (buf) * GEMM_BUF + ((tid >> 3) + 32 * j) * GEMM_LDT + (tid & 7) * 8) = ab[j]; \
        if constexpr (SUMSQ) { _Pragma("unroll") for (int q = 0; q < 4; ++q) { const float lo = bflo(ab[j][q]), hi = bfhi(ab[j][q]); ss[j] += lo * lo + hi * hi; } } } } \
    _Pragma("unroll") for (int j = 0; j < 4; ++j) \
        *(u32x4*)(Bs + (buf) * GEMM_BUF + ((tid >> 3) + 32 * j) * GEMM_LDT + (tid & 7) * 8) = bb[j]; } while (0)

  __syncthreads();
  G_LOAD(0);
  S_STORE(0);
  __syncthreads();
  for (int kt = 0; kt < nk; ++kt) {
    const int cur = kt & 1;
    if (kt + 1 < nk) G_LOAD(kt + 1);
    const u16* Ac = As + cur * GEMM_BUF + (wm * 64 + r) * GEMM_LDT + h * 8;
    const u16* Bc = Bs + cur * GEMM_BUF + (wn * 64 + r) * GEMM_LDT + h * 8;
#pragma unroll
    for (int ks = 0; ks < 4; ++ks) {
      const bf16x8 a0 = *(const bf16x8*)(Ac + ks * 16);
      const bf16x8 a1 = *(const bf16x8*)(Ac + 32 * GEMM_LDT + ks * 16);
      const bf16x8 b0 = *(const bf16x8*)(Bc + ks * 16);
      const bf16x8 b1 = *(const bf16x8*)(Bc + 32 * GEMM_LDT + ks * 16);
      acc[0][0] = mfma32(a0, b0, acc[0][0]);
      acc[0][1] = mfma32(a0, b1, acc[0][1]);
      acc[1][0] = mfma32(a1, b0, acc[1][0]);
      acc[1][1] = mfma32(a1, b1, acc[1][1]);
    }
    if (kt + 1 < nk) S_STORE(cur ^ 1);
    __syncthreads();
  }
#undef G_LOAD
#undef S_STORE
  if constexpr (SUMSQ) {
    if constexpr (AF32) {
#pragma unroll
      for (int j = 0; j < 8; ++j) {
        float vv = ss[j];
        vv += __shfl_xor(vv, 8); vv += __shfl_xor(vv, 4); vv += __shfl_xor(vv, 2); vv += __shfl_xor(vv, 1);
        if ((tid & 15) == 0) rowss[(tid >> 4) + 16 * j] = frsq(vv * invK + EPS);
      }
    } else {
#pragma unroll
      for (int j = 0; j < 4; ++j) {
        float vv = ss[j];
        vv += __shfl_xor(vv, 4); vv += __shfl_xor(vv, 2); vv += __shfl_xor(vv, 1);
        if ((tid & 7) == 0) rowss[(tid >> 3) + 32 * j] = frsq(vv * invK + EPS);
      }
    }
    __syncthreads();
  }
}

DI void acc_zero(f32x16 (&acc)[2][2]) {
#pragma unroll
  for (int a = 0; a < 2; ++a)
#pragma unroll
    for (int b = 0; b < 2; ++b)
#pragma unroll
      for (int i = 0; i < 16; ++i) acc[a][b][i] = 0.f;
}

DI void acc_to_cs(const f32x16 (&acc)[2][2], float* Cs) {
  const int tid = otid(), lane = tid & 63, w = tid >> 6, wm = w >> 1, wn = w & 1, r = lane & 31, h = lane >> 5;
  float* base = Cs + (wm * 64 + 4 * h) * CS_LD + wn * 64 + r;
#pragma unroll
  for (int mb = 0; mb < 2; ++mb)
#pragma unroll
    for (int nb = 0; nb < 2; ++nb)
#pragma unroll
      for (int i = 0; i < 16; ++i) base[(mb * 32 + (i & 3) + 8 * (i >> 2)) * CS_LD + nb * 32] = acc[mb][nb][i];
}
#define EPI_ROWS(...) do { const int _t = otid(); \
    _Pragma("unroll 2") for (int _ps = 0; _ps < 8; ++_ps) { const int m = _ps * 16 + (_t >> 4); \
      _Pragma("unroll") for (int _hf = 0; _hf < 2; ++_hf) { const int n = _hf * 64 + (_t & 15) * 4; \
        f32x4 val = *(const f32x4*)(Cs + m * CS_LD + n); __VA_ARGS__ } } } while (0)
DI u32x2 pack4(f32x4 v, float sc) { u32x2 o; o[0] = cvtpk(v[0] * sc, v[1] * sc); o[1] = cvtpk(v[2] * sc, v[3] * sc); return o; }

DI void store_vt(const float* Cs, const float* rstd, u16* Vt, int c0, int ncols, int bh0, int s0) {
  for (int idx = otid(); idx < ncols * 4; idx += NTHR) {
    const int cc = idx % ncols, mq = idx / ncols;
    const float* src = Cs + (mq * 32) * CS_LD + c0 + cc;
    const float* rsp = rstd + mq * 32;
    u16* dst = Vt + ((size_t)(bh0 + (cc >> 6)) * 64 + (cc & 63)) * S_ + s0 + mq * 32;
#pragma unroll
    for (int q = 0; q < 4; ++q) {
      u32x4 o;
#pragma unroll
      for (int e = 0; e < 4; ++e) o[e] = cvtpk(src[(q * 8 + 2 * e) * CS_LD] * rsp[q * 8 + 2 * e], src[(q * 8 + 2 * e + 1) * CS_LD] * rsp[q * 8 + 2 * e + 1]);
      *(u32x4*)(dst + q * 8) = o;
    }
  }
}

DI void phase_mla_in(const Params& P, int l, const float* xcur, unsigned char* smem, int v, int G) {
  u16* sm = (u16*)smem; float* rowss = (float*)(smem + SMEM_ROWSS); float* Cs = (float*)smem;
  const u16* Wt = (const u16*)(P.ws + WS_W) + l * W_MLA_SZ;
  u16* CQ = (u16*)(P.ws + WS_CQ); u16* GATE = (u16*)(P.ws + WS_GATE); u16* KROPE = (u16*)(P.ws + WS_KROPE);
  for (int tile = v; tile < 128 * 14; tile += G) {
    const int mt = tile / 14, nt = tile - mt * 14;
    f32x16 acc[2][2]; acc_zero(acc);
    gemm_main<true, true>(xcur + (size_t)mt * 128 * 1024, 1024, Wt + (size_t)nt * 128 * 1024, 1024, 1024, acc, sm, rowss, 1.f / 1024.f);
    acc_to_cs(acc, Cs);
    __syncthreads();
    const int t0 = mt * 128;
    if (nt < 5) {
      EPI_ROWS({ *(u32x2*)(CQ + (size_t)(t0 + m) * 640 + nt * 128 + n) = pack4(val, rowss[m]); });
    } else if (nt < 13) {
      EPI_ROWS({ *(u32x2*)(GATE + (size_t)(t0 + m) * 1024 + (nt - 5) * 128 + n) = pack4(val, rowss[m]); });
    } else {
      EPI_ROWS({ if (n < 32) *(u32x2*)(KROPE + (size_t)(t0 + m) * 32 + n) = pack4(val, rowss[m]); });
    }
  }
}

DI void phase_mla_qkv(const Params& P, int l, unsigned char* smem, int v, int G) {
  u16* sm = (u16*)smem; float* rowss = (float*)(smem + SMEM_ROWSS); float* Cs = (float*)smem;
  const u16* Wt = (const u16*)(P.ws + WS_W) + l * W_MLA_SZ;
  const u16* CQ = (const u16*)(P.ws + WS_CQ); u16* QRAW = (u16*)(P.ws + WS_XA);
  const u16* KROPE = (const u16*)(P.ws + WS_KROPE);
  u16* KBUF = (u16*)(P.ws + WS_KBUF); u16* VT = (u16*)(P.ws + WS_VT);
  const float* cosT = (const float*)(P.ws + WS_COS); const float* sinT = (const float*)(P.ws + WS_SIN);
  const float* gk = P.mla_k_head_g + l * 96;
  const int tid = otid();
  for (int tile = v; tile < 128 * 12 + 128 * 16; tile += G) {
    f32x16 acc[2][2]; acc_zero(acc);
    if (tile < 128 * 12) {
      const int mt = tile / 12, nt = tile - mt * 12, t0 = mt * 128;
      gemm_main<false, true>(CQ + (size_t)t0 * 640, 640, Wt + W_MLA_Q + (size_t)nt * 128 * 384, 384, 384, acc, sm, rowss, 1.f / 384.f);
      acc_to_cs(acc, Cs);
      __syncthreads();
      EPI_ROWS({ *(u32x2*)(QRAW + (size_t)(t0 + m) * 1536 + nt * 128 + n) = pack4(val, rowss[m]); });
    } else {
      const int tk = tile - 128 * 12;
      const int mt = tk >> 4, hh = tk & 15, t0 = mt * 128;
      gemm_main<false, true>(CQ + (size_t)t0 * 640 + 384, 640, Wt + W_MLA_KV + (size_t)hh * 128 * 256, 256, 256, acc, sm, rowss, 1.f / 256.f);
      acc_to_cs(acc, Cs);
      __syncthreads();
      const int b = t0 >> 11, s0 = t0 & 2047, bh = b * 16 + hh;
      {
        const int m = tid >> 1, hf = tid & 1, t = t0 + m;
        const float* crow_p = Cs + m * CS_LD + hf * 32;
        f32x4 kn[8];
#pragma unroll
        for (int q = 0; q < 8; ++q) kn[q] = *(const f32x4*)(crow_p + q * 4) * rowss[m];
        const u32x4 r1 = *(const u32x4*)(KROPE + (size_t)t * 32 + hf * 8);
        const u32x4 r2 = *(const u32x4*)(KROPE + (size_t)t * 32 + 16 + hf * 8);
        float x1[8], x2[8];
#pragma unroll
        for (int q = 0; q < 4; ++q) { x1[2 * q] = bflo(r1[q]); x1[2 * q + 1] = bfhi(r1[q]); x2[2 * q] = bflo(r2[q]); x2[2 * q + 1] = bfhi(r2[q]); }
        float ssq = 0.f;
#pragma unroll
        for (int q = 0; q < 8; ++q) { ssq += kn[q][0] * kn[q][0] + kn[q][1] * kn[q][1] + kn[q][2] * kn[q][2] + kn[q][3] * kn[q][3]; ssq += x1[q] * x1[q] + x2[q] * x2[q]; }
        ssq += __shfl_xor(ssq, 1);
        const float rs = frsq(ssq * (1.f / 96.f) + EPS);
        u16* kdst = KBUF + ((size_t)bh * S_ + s0 + m) * 96;
#pragma unroll
        for (int q = 0; q < 4; ++q) {
          u32x4 o;
#pragma unroll
          for (int e = 0; e < 2; ++e) {
            const f32x4 a = kn[2 * q + e]; const int d = hf * 32 + q * 8 + e * 4;
            o[2 * e]     = cvtpk(a[0] * rs * gk[d], a[1] * rs * gk[d + 1]);
            o[2 * e + 1] = cvtpk(a[2] * rs * gk[d + 2], a[3] * rs * gk[d + 3]);
          }
          *(u32x4*)(kdst + hf * 32 + q * 8) = o;
        }
        float o1[8], o2[8];
#pragma unroll
        for (int q = 0; q < 8; ++q) {
          const int idx = hf * 8 + q;
          const float a1 = x1[q] * rs * gk[64 + idx], a2 = x2[q] * rs * gk[80 + idx];
          const float c = cosT[t * 16 + idx], s = sinT[t * 16 + idx];
          o1[q] = a1 * c - a2 * s; o2[q] = a2 * c + a1 * s;
        }
        u32x4 w1, w2;
#pragma unroll
        for (int q = 0; q < 4; ++q) { w1[q] = cvtpk(o1[2 * q], o1[2 * q + 1]); w2[q] = cvtpk(o2[2 * q], o2[2 * q + 1]); }
        *(u32x4*)(kdst + 64 + hf * 8) = w1;
        *(u32x4*)(kdst + 80 + hf * 8) = w2;
      }
      store_vt(Cs, rowss, VT, 64, 64, bh, s0);
    }
  }
}

template <bool MLA>
DI void attn_item(const Params& P, int l, int bh, int qb, u16* sm) {
  constexpr int DK = MLA ? 96 : 64, KSTR = DK + 8, NKS = DK / 16, NKCH = MLA ? 3 : 2;
  u16* Qs = sm; u16* Ks = Qs + 128 * KSTR; u16* Vs = Ks + 2 * 64 * KSTR;
  const int tid = otid(), lane = tid & 63, w = tid >> 6, r = lane & 31, h = lane >> 5;
  const int b = bh >> 4, hh = bh & 15;
  const int tq0 = b * S_ + qb * 128;
  const u16* Kg = (const u16*)(P.ws + WS_KBUF) + (size_t)bh * S_ * DK;
  const u16* Vg = (const u16*)(P.ws + WS_VT) + (size_t)bh * 64 * S_;
  u16* GATE = (u16*)(P.ws + WS_GATE);
  const int nkt = 2 * qb + 2;
  u32x4 kreg[NKCH]; u32x4 vreg[2];

#define KV_LOAD(kt) do { \
    const u16* _kg = Kg + (size_t)(kt) * 64 * DK; \
    _Pragma("unroll") for (int j = 0; j < NKCH; ++j) kreg[j] = *(const u32x4*)(_kg + (size_t)(tid + 256 * j) * 8); \
    _Pragma("unroll") for (int j = 0; j < 2; ++j) { const int c = tid + 256 * j; vreg[j] = *(const u32x4*)(Vg + (size_t)(c >> 3) * S_ + (kt) * 64 + (c & 7) * 8); } } while (0)
#define KV_STORE(buf) do { \
    _Pragma("unroll") for (int j = 0; j < NKCH; ++j) { const int c = tid + 256 * j; \
      const int key = MLA ? c / 12 : c >> 3; const int cc = MLA ? c - key * 12 : c & 7; \
      *(u32x4*)(Ks + (buf) * 64 * KSTR + key * KSTR + cc * 8) = kreg[j]; } \
    _Pragma("unroll") for (int j = 0; j < 2; ++j) { const int c = tid + 256 * j; \
      u16* _d = Vs + (buf) * 64 * 68 + (c >> 3) * 68 + (c & 7) * 8; \
      u32x2 lo2; lo2[0] = vreg[j][0]; lo2[1] = vreg[j][1]; u32x2 hi2; hi2[0] = vreg[j][2]; hi2[1] = vreg[j][3]; \
      *(u32x2*)_d = lo2; *(u32x2*)(_d + 4) = hi2; } } while (0)

  __syncthreads();
  {
    const int kt0 = MLA ? 0 : nkt - 1;
    KV_LOAD(kt0);
  }
  if constexpr (MLA) {
    const u16* QRAW = (const u16*)(P.ws + WS_XA);
    const float* gq = P.mla_q_head_g + l * 96;
    const float* cosT = (const float*)(P.ws + WS_COS); const float* sinT = (const float*)(P.ws + WS_SIN);
    const int m = tid >> 1, hf = tid & 1, t = tq0 + m;
    const u16* src = QRAW + (size_t)t * 1536 + hh * 96 + hf * 48;
    float q[48];
#pragma unroll
    for (int c = 0; c < 6; ++c) {
      const u32x4 u = *(const u32x4*)(src + c * 8);
#pragma unroll
      for (int e = 0; e < 4; ++e) { q[c * 8 + 2 * e] = bflo(u[e]); q[c * 8 + 2 * e + 1] = bfhi(u[e]); }
    }
    float ssq = 0.f;
#pragma unroll
    for (int d = 0; d < 48; ++d) ssq += q[d] * q[d];
    ssq += __shfl_xor(ssq, 1);
    const float rs = frsq(ssq * (1.f / 96.f) + EPS) * (0.10206207261596575f * LOG2E);
#pragma unroll
    for (int d = 0; d < 48; ++d) q[d] = q[d] * rs * gq[hf * 48 + d];
    if (hf) {
#pragma unroll
      for (int i2 = 0; i2 < 16; ++i2) {
        const float c = cosT[t * 16 + i2], s = sinT[t * 16 + i2];
        const float a1 = q[16 + i2], a2 = q[32 + i2];
        q[16 + i2] = a1 * c - a2 * s; q[32 + i2] = a2 * c + a1 * s;
      }
    }
    u16* qd = Qs + m * KSTR + hf * 48;
#pragma unroll
    for (int c = 0; c < 6; ++c) {
      u32x4 o;
#pragma unroll
      for (int e = 0; e < 4; ++e) o[e] = cvtpk(q[c * 8 + 2 * e], q[c * 8 + 2 * e + 1]);
      *(u32x4*)(qd + c * 8) = o;
    }
  } else {
    const u16* QSB = (const u16*)(P.ws + WS_XA);
#pragma unroll
    for (int j = 0; j < 4; ++j) {
      const int c = tid + 256 * j, row = c >> 3, c8 = c & 7;
      const u32x4 u = *(const u32x4*)(QSB + (size_t)(tq0 + row) * 1024 + hh * 64 + c8 * 8);
      *(u32x4*)(Qs + row * KSTR + c8 * 8) = u;
    }
  }
  KV_STORE(0);
  __syncthreads();
  bf16x8 qf[NKS];
#pragma unroll
  for (int s = 0; s < NKS; ++s) qf[s] = *(const bf16x8*)(Qs + (w * 32 + r) * KSTR + 16 * s + 8 * h);

  f32x16 O[2];
#pragma unroll
  for (int i = 0; i < 16; ++i) { O[0][i] = 0.f; O[1][i] = 0.f; }
  float m_run = -1e30f, lsum = 0.f, carry = 0.f;
  const int q0 = qb * 128 + w * 32;

  for (int it = 0; it < nkt; ++it) {
    const int kt = MLA ? it : nkt - 1 - it;
    const int cur = it & 1;
    if (it + 1 < nkt) { const int ktn = MLA ? it + 1 : nkt - 2 - it; KV_LOAD(ktn); }
    const int kbase = kt * 64;
    const bool active = MLA ? (kbase <= q0 + 31) : (kbase <= q0 + 30);
    if (active) {
      const u16* Kc = Ks + cur * 64 * KSTR + r * KSTR + 8 * h;
      const u16* Vc = Vs + cur * 64 * 68 + r * 68 + 4 * h;
      f32x16 st[2];
#pragma unroll
      for (int i = 0; i < 16; ++i) { st[0][i] = 0.f; st[1][i] = 0.f; }
#pragma unroll
      for (int s = 0; s < NKS; ++s) {
        const bf16x8 k0 = *(const bf16x8*)(Kc + 16 * s);
        const bf16x8 k1 = *(const bf16x8*)(Kc + 32 * KSTR + 16 * s);
        st[0] = mfma32(k0, qf[s], st[0]);
        st[1] = mfma32(k1, qf[s], st[1]);
      }
      bf16x8 pf[2][2];
      if constexpr (MLA) {
        if (kbase + 63 > q0) {
#pragma unroll
          for (int kb = 0; kb < 2; ++kb)
#pragma unroll
            for (int i = 0; i < 16; ++i) { const int key = kbase + kb * 32 + crow(i, h); if (key > q0 + r) st[kb][i] = -1e30f; }
        }
        float mx = st[0][0];
#pragma unroll
        for (int i = 1; i < 16; ++i) mx = fmaxf(mx, st[0][i]);
#pragma unroll
        for (int i = 0; i < 16; ++i) mx = fmaxf(mx, st[1][i]);
        mx = pair_max(mx);
        const float mnew = fmaxf(m_run, mx);
        const float alpha = fexp2(m_run - mnew);
        m_run = mnew;
        float psum = 0.f;
#pragma unroll
        for (int kb = 0; kb < 2; ++kb)
#pragma unroll
          for (int i = 0; i < 16; ++i) { const float pv = fexp2(st[kb][i] - mnew); st[kb][i] = pv; psum += pv; }
        lsum = lsum * alpha + psum;
#pragma unroll
        for (int i = 0; i < 16; ++i) { O[0][i] *= alpha; O[1][i] *= alpha; }
      } else {
        const bool msk = (kbase + 63 >= q0);
        f32x16 L[2];
#pragma unroll
        for (int kb = 0; kb < 2; ++kb)
#pragma unroll
          for (int i = 0; i < 16; ++i) {
            const float z = st[kb][i];
            const float u = fexp2(fminf(z, 80.f));
            const float sp = flog2(1.f + u);
            float lom = -sp, lb = z - sp;
            if (msk) { const int key = kbase + kb * 32 + crow(i, h); const bool valid = key < q0 + r; lom = valid ? lom : 0.f; lb = valid ? lb : -1e30f; }
            L[kb][i] = lom; st[kb][i] = lb;
          }
        float Rr[2][4], Rp[2][4], E[2][4];
#pragma unroll
        for (int kb = 0; kb < 2; ++kb)
#pragma unroll
          for (int g = 0; g < 4; ++g) { Rr[kb][g] = (L[kb][4 * g] + L[kb][4 * g + 1]) + (L[kb][4 * g + 2] + L[kb][4 * g + 3]); Rp[kb][g] = pair_other(Rr[kb][g], h); }
        float run = 0.f;
#pragma unroll
        for (int idx = 7; idx >= 0; --idx) { const int kb = idx >> 2, g = idx & 3; E[kb][g] = run; run += Rr[kb][g] + Rp[kb][g]; }
#pragma unroll
        for (int kb = 0; kb < 2; ++kb)
#pragma unroll
          for (int g = 0; g < 4; ++g) {
            const float t3 = carry + E[kb][g] + (h == 0 ? Rp[kb][g] : 0.f);
            const float t2 = t3 + L[kb][4 * g + 3];
            const float t1 = t2 + L[kb][4 * g + 2];
            const float t0 = t1 + L[kb][4 * g + 1];
            st[kb][4 * g + 3] = fexp2(st[kb][4 * g + 3] + t3);
            st[kb][4 * g + 2] = fexp2(st[kb][4 * g + 2] + t2);
            st[kb][4 * g + 1] = fexp2(st[kb][4 * g + 1] + t1);
            st[kb][4 * g + 0] = fexp2(st[kb][4 * g + 0] + t0);
          }
        carry += run;
      }
#pragma unroll
      for (int kb = 0; kb < 2; ++kb)
#pragma unroll
        for (int s2 = 0; s2 < 2; ++s2) {
          u32x4 pk;
#pragma unroll
          for (int e = 0; e < 4; ++e) pk[e] = cvtpk(st[kb][8 * s2 + 2 * e], st[kb][8 * s2 + 2 * e + 1]);
          pf[kb][s2] = __builtin_bit_cast(bf16x8, pk);
        }
#pragma unroll
      for (int db = 0; db < 2; ++db)
#pragma unroll
        for (int kb = 0; kb < 2; ++kb)
#pragma unroll
          for (int s2 = 0; s2 < 2; ++s2) {
            const u16* vp = Vc + db * 32 * 68 + kb * 32 + 16 * s2;
            const u32x2 lo2 = *(const u32x2*)vp;
            const u32x2 hi2 = *(const u32x2*)(vp + 8);
            u32x4 vv; vv[0] = lo2[0]; vv[1] = lo2[1]; vv[2] = hi2[0]; vv[3] = hi2[1];
            O[db] = mfma32(__builtin_bit_cast(bf16x8, vv), pf[kb][s2], O[db]);
          }
    }
    if (it + 1 < nkt) KV_STORE(cur ^ 1);
    __syncthreads();
  }
#undef KV_LOAD
#undef KV_STORE
  float inv = 1.f;
  if constexpr (MLA) { const float lt = pair_sum(lsum); inv = frcp(lt); }
  float* Ob = (float*)(Qs + w * 32 * KSTR);
#pragma unroll
  for (int db = 0; db < 2; ++db) {
    __builtin_amdgcn_s_waitcnt(0xc07f);
    __builtin_amdgcn_wave_barrier();
#pragma unroll
    for (int i = 0; i < 16; ++i) Ob[r * 33 + crow(i, h)] = O[db][i] * inv;
    __builtin_amdgcn_s_waitcnt(0xc07f);
    __builtin_amdgcn_wave_barrier();
    const int qq = lane >> 1, dh = (lane & 1) * 16;
    u16* gp = GATE + (size_t)(tq0 + w * 32 + qq) * 1024 + hh * 64 + db * 32 + dh;
    const u32x4 g0 = *(const u32x4*)gp, g1 = *(const u32x4*)(gp + 8);
    float ov[16];
#pragma unroll
    for (int e = 0; e < 16; ++e) ov[e] = Ob[qq * 33 + dh + e];
    u32x4 o0, o1;
#pragma unroll
    for (int e = 0; e < 4; ++e) {
      o0[e] = cvtpk(silu_mul(ov[2 * e], bflo(g0[e])), silu_mul(ov[2 * e + 1], bfhi(g0[e])));
      o1[e] = cvtpk(silu_mul(ov[8 + 2 * e], bflo(g1[e])), silu_mul(ov[8 + 2 * e + 1], bfhi(g1[e])));
    }
    *(u32x4*)gp = o0; *(u32x4*)(gp + 8) = o1;
  }
}

template <bool MLA>
DI void phase_attn(const Params& P, int l, unsigned char* smem, int v, int G) {
  for (int pi = v; pi < 1024; pi += G) {
    const int bh = pi >> 3, a = pi & 7;
    attn_item<MLA>(P, l, bh, a, (u16*)smem);
    attn_item<MLA>(P, l, bh, 15 - a, (u16*)smem);
  }
}

DI void phase_out(const Params& P, const u16* Wout, const float* xres, unsigned char* smem, int v, int G) {
  u16* sm = (u16*)smem; float* rowss = (float*)(smem + SMEM_ROWSS); float* Cs = (float*)smem;
  const u16* OG = (const u16*)(P.ws + WS_GATE); float* XA = (float*)(P.ws + WS_XA);
  for (int tile = v; tile < 128 * 8; tile += G) {
    const int mt = tile >> 3, nt = tile & 7, t0 = mt * 128;
    f32x16 acc[2][2]; acc_zero(acc);
    gemm_main<false, false>(OG + (size_t)t0 * 1024, 1024, Wout + (size_t)nt * 128 * 1024, 1024, 1024, acc, sm, rowss, 0.f);
    acc_to_cs(acc, Cs);
    __syncthreads();
    EPI_ROWS({ const size_t o = (size_t)(t0 + m) * 1024 + nt * 128 + n; *(f32x4*)(XA + o) = *(const f32x4*)(xres + o) + val; });
  }
}

DI void phase_ple(const Params& P, int li, unsigned char* smem, int v, int G) {
  u16* sm = (u16*)smem; float* rowss = (float*)(smem + SMEM_ROWSS); float* Cs = (float*)smem;
  const float* XA = (const float*)(P.ws + WS_XA);
  const u16* Wg = (const u16*)(P.ws + WS_W) + W_PLE + li * W_PLE_SZ; const u16* Wp = Wg + (size_t)1024 * 1024;
  const float* pin = P.p + (size_t)li * T_ * 256;
  for (int tile = v; tile < 128 * 8; tile += G) {
    const int mt = tile >> 3, nt = tile & 7, t0 = mt * 128;
    f32x16 acc[2][2]; acc_zero(acc);
    gemm_main<true, false>(XA + (size_t)t0 * 1024, 1024, Wg + (size_t)nt * 128 * 1024, 1024, 1024, acc, sm, rowss, 0.f);
#pragma unroll
    for (int a = 0; a < 2; ++a)
#pragma unroll
      for (int b = 0; b < 2; ++b)
#pragma unroll
        for (int i = 0; i < 16; ++i) acc[a][b][i] = frcp(1.f + fexp2(-acc[a][b][i] * LOG2E));
    {
      f32x16 acu[2][2]; acc_zero(acu);
      gemm_main<true, false>(pin + (size_t)t0 * 256, 256, Wp + (size_t)nt * 128 * 256, 256, 256, acu, sm, rowss, 0.f);
#pragma unroll
      for (int a = 0; a < 2; ++a)
#pragma unroll
        for (int b = 0; b < 2; ++b) acc[a][b] *= acu[a][b];
    }
    acc_to_cs(acc, Cs);
    __syncthreads();
    EPI_ROWS({ const size_t o = (size_t)(t0 + m) * 1024 + nt * 128 + n; *(f32x4*)(P.out + o) = *(const f32x4*)(XA + o) + val; });
  }
}

DI void phase_sb_in(const Params& P, int j, unsigned char* smem, int v, int G) {
  u16* sm = (u16*)smem; float* rowss = (float*)(smem + SMEM_ROWSS); float* Cs = (float*)smem;
  const u16* Wt = (const u16*)(P.ws + WS_W) + (j == 0 ? W_SB0 : W_SB1);
  const int NT = (j == 0) ? 32 : 16;
  u16* QSB = (u16*)(P.ws + WS_XA); u16* GATE = (u16*)(P.ws + WS_GATE);
  u16* KSH = (u16*)(P.ws + WS_KBUF); u16* VT = (u16*)(P.ws + WS_VT);
  const float* xcur = P.out;
  for (int tile = v; tile < 128 * NT; tile += G) {
    const int mt = tile / NT, nt = tile - mt * NT, t0 = mt * 128;
    f32x16 acc[2][2]; acc_zero(acc);
    gemm_main<true, true>(xcur + (size_t)t0 * 1024, 1024, Wt + (size_t)nt * 128 * 1024, 1024, 1024, acc, sm, rowss, 1.f / 1024.f);
    const int b = t0 >> 11, s0 = t0 & 2047;
    acc_to_cs(acc, Cs);
    __syncthreads();
    if (nt < 8) {
      EPI_ROWS({ *(u32x2*)(QSB + (size_t)(t0 + m) * 1024 + nt * 128 + n) = pack4(val, rowss[m]); });
    } else if (nt < 16) {
      EPI_ROWS({ *(u32x2*)(GATE + (size_t)(t0 + m) * 1024 + (nt - 8) * 128 + n) = pack4(val, rowss[m]); });
    } else if (nt < 24) {
      EPI_ROWS({ const int c = (nt - 16) * 128 + n;
                 *(u32x2*)(KSH + ((size_t)(b * 16 + (c >> 6)) * S_ + s0 + m) * 64 + (c & 63)) = pack4(val, rowss[m]); });
    } else {
      store_vt(Cs, rowss, VT, 0, 128, b * 16 + (nt - 24) * 2, s0);
    }
  }
}

__global__ void __launch_bounds__(NTHR, 2) yoco_fwd(Params P) {
  extern __shared__ __attribute__((aligned(16))) unsigned char smem[];
  const int G = gridDim.x, bx = blockIdx.x;
  const int v = (G % 8 == 0) ? (bx % 8) * (G / 8) + bx / 8 : bx;
  volatile LAS unsigned* st = (volatile LAS unsigned*)(smem + SMEM_ST);
  if (threadIdx.x < 4) st[threadIdx.x] = 0u;
  __syncthreads();
  XcdBarrier bar = xcd_barrier_post((unsigned*)(P.ws + WS_BAR), st);

  phase_prep(P, smem, v, G);
  cg::this_grid().sync();

  const u16* W = (const u16*)(P.ws + WS_W);
#pragma unroll 1
  for (int l = 0; l < 2; ++l) {
    const float* xcur = (l == 0) ? P.x : P.out;
    phase_mla_in(P, l, xcur, smem, v, G);
    xcd_barrier(bar);
    phase_mla_qkv(P, l, smem, v, G);
    xcd_barrier(bar);
    phase_attn<true>(P, l, smem, v, G);
    xcd_barrier(bar);
    phase_out(P, W + l * W_MLA_SZ + W_MLA_OUT, xcur, smem, v, G);
    xcd_barrier(bar);
    phase_ple(P, l, smem, v, G);
    xcd_barrier(bar);
  }
#pragma unroll 1
  for (int j = 0; j < 2; ++j) {
    phase_sb_in(P, j, smem, v, G);
    xcd_barrier(bar);
    phase_attn<false>(P, j, smem, v, G);
    xcd_barrier(bar);
    phase_out(P, W + (j == 0 ? W_SB0_OUT : W_SB1_OUT), P.out, smem, v, G);
    xcd_barrier(bar);
    phase_ple(P, 2 + j, smem, v, G);
    if (j == 0) xcd_barrier(bar);
  }
}

extern "C" void kernel_launch(void* const* d_in, const int* in_sizes, int n_in, void* d_out, int out_size,
                              void* d_ws, size_t ws_size, hipStream_t stream) {
  static int grid_blocks = 0;
  if (!grid_blocks) {
    int dev = 0, cus = 0, per_cu = 0;
    hipGetDevice(&dev);
    hipDeviceGetAttribute(&cus, hipDeviceAttributeMultiprocessorCount, dev);
    hipFuncSetAttribute((const void*)yoco_fwd, hipFuncAttributeMaxDynamicSharedMemorySize, SMEM_BYTES);
    hipOccupancyMaxActiveBlocksPerMultiprocessor(&per_cu, (const void*)yoco_fwd, NTHR, SMEM_BYTES);
    if (per_cu > 2) per_cu = 2;
    if (per_cu < 1) per_cu = 1;
    grid_blocks = cus * per_cu;
    if (ws_size < WS_END) fprintf(stderr, "kernel_launch: workspace too small: %zu < %zu\n", ws_size, (size_t)WS_END);
  }
  Params P{};
  P.x = (const float*)d_in[0]; P.p = (const float*)d_in[1]; P.pos = (const int*)d_in[2];
  P.mla_ln_g = (const float*)d_in[3]; P.mla_w_in = (const float*)d_in[4]; P.mla_q_norm_g = (const float*)d_in[5];
  P.mla_kv_norm_g = (const float*)d_in[6]; P.mla_w_q_up = (const float*)d_in[7]; P.mla_w_kv_up = (const float*)d_in[8];
  P.mla_q_head_g = (const float*)d_in[9]; P.mla_k_head_g = (const float*)d_in[10]; P.mla_w_out = (const float*)d_in[11];
  P.kv_ln_g = (const float*)d_in[12]; P.w_kv_shared = (const float*)d_in[13]; P.sb_ln_g = (const float*)d_in[14];
  P.sb_w_in = (const float*)d_in[15]; P.sb_w_out = (const float*)d_in[16]; P.ple_w_proj = (const float*)d_in[17];
  P.ple_w_gate = (const float*)d_in[18];
  P.out = (float*)d_out; P.ws = (unsigned char*)d_ws;
  hipMemsetAsync((char*)d_ws + WS_BAR, 0, 16384, stream);
  void* args[] = {&P};
  hipError_t e = hipLaunchCooperativeKernel((const void*)yoco_fwd, dim3(grid_blocks), dim3(NTHR), args, SMEM_BYTES, stream);
  if (e != hipSuccess) fprintf(stderr, "cooperative launch failed: %s (grid %d)\n", hipGetErrorString(e), grid_blocks);
}
```

```cpp
#include <hip/hip_runtime.h>
#include <hip/hip_cooperative_groups.h>
#include <cstdio>
#include <cstdint>
namespace cg = cooperative_groups;
#pragma clang fp reassociate(on) contract(fast)

typedef unsigned short u16;
using bf16x8 = __attribute__((ext_vector_type(8))) short;
using f32x16 = __attribute__((ext_vector_type(16))) float;
using f32x4  = __attribute__((ext_vector_type(4))) float;
using u32x4  = __attribute__((ext_vector_type(4))) unsigned;
using u32x2  = __attribute__((ext_vector_type(2))) unsigned;
typedef float f32x2_t __attribute__((ext_vector_type(2)));
typedef __bf16 bf16x2_t __attribute__((ext_vector_type(2)));
#define DI __device__ __forceinline__
#define LAS __attribute__((address_space(3)))

constexpr int T_ = 16384, S_ = 2048;
constexpr float EPS = 1e-6f;
constexpr float LOG2E = 1.4426950408889634f;
constexpr int NTHR = 256;
constexpr int LDX = 1024;
constexpr int LDQR = 1536;
constexpr int LDCQ = 640;
constexpr int VT_LD = 2112;
constexpr int KP1024 = 1024, KP384 = 384, KP256 = 256;

constexpr size_t WS_BAR  = 0;
constexpr size_t WS_COS  = 16384;
constexpr size_t WS_SIN  = WS_COS + (size_t)T_ * 16 * 4;
constexpr size_t WS_W    = WS_SIN + (size_t)T_ * 16 * 4;
constexpr size_t W_MLA_SZ  = (size_t)1792 * KP1024 + 1536 * KP384 + 2048 * KP256 + 1024 * KP1024;
constexpr size_t W_MLA_Q   = (size_t)1792 * KP1024;
constexpr size_t W_MLA_KV  = W_MLA_Q + (size_t)1536 * KP384;
constexpr size_t W_MLA_OUT = W_MLA_KV + (size_t)2048 * KP256;
constexpr size_t W_SB0     = 2 * W_MLA_SZ;
constexpr size_t W_SB0_OUT = W_SB0 + (size_t)4096 * KP1024;
constexpr size_t W_SB1     = W_SB0_OUT + (size_t)1024 * KP1024;
constexpr size_t W_SB1_OUT = W_SB1 + (size_t)2048 * KP1024;
constexpr size_t W_PLE     = W_SB1_OUT + (size_t)1024 * KP1024;
constexpr size_t W_PLE_SZ  = (size_t)1024 * KP1024 + 1024 * KP256;
constexpr size_t W_TOTAL   = W_PLE + 4 * W_PLE_SZ;
constexpr size_t WS_XA    = (WS_W + W_TOTAL * 2 + 255) / 256 * 256;
constexpr size_t WS_XB    = WS_XA + (size_t)T_ * LDX * 2;
constexpr size_t WS_CQ    = WS_XA + (size_t)T_ * LDX * 4;
constexpr size_t WS_GATE  = WS_CQ + (size_t)T_ * LDCQ * 2;
constexpr size_t WS_KROPE = WS_GATE + (size_t)T_ * LDX * 2;
constexpr size_t WS_KBUF  = WS_KROPE + (size_t)T_ * 32 * 2;
constexpr size_t WS_VT    = WS_KBUF + (size_t)T_ * 16 * 96 * 2;
constexpr size_t WS_PB    = WS_VT + (size_t)T_ * 1024 * 2;
constexpr size_t WS_END   = WS_PB + (size_t)T_ * 256 * 2;
static_assert((size_t)T_ * LDQR * 2 <= (size_t)T_ * LDX * 4, "q_raw fits the XA region");
static_assert(WS_XA % 256 == 0 && WS_END <= (size_t)256 * 1024 * 1024, "workspace map");

constexpr int GEMM_LDT = 40;
constexpr int SMEM_MAIN = 73728;
constexpr int SMEM_ROWSS = SMEM_MAIN;
constexpr int SMEM_ST = SMEM_MAIN + 512;
constexpr int SMEM_BYTES = SMEM_ST + 16;
constexpr int CS_LD = 132;

struct Params {
  const float* x; const float* p; const int* pos;
  const float* mla_ln_g; const float* mla_w_in; const float* mla_q_norm_g; const float* mla_kv_norm_g;
  const float* mla_w_q_up; const float* mla_w_kv_up; const float* mla_q_head_g; const float* mla_k_head_g;
  const float* mla_w_out; const float* kv_ln_g; const float* w_kv_shared; const float* sb_ln_g;
  const float* sb_w_in; const float* sb_w_out; const float* ple_w_proj; const float* ple_w_gate;
  float* out; unsigned char* ws;
};

__device__ const float c_inv_freq[16] = {
  1.000000000e+00f, 5.623413324e-01f, 3.162277639e-01f, 1.778279394e-01f, 1.000000015e-01f, 5.623412877e-02f,
  3.162277862e-02f, 1.778279431e-02f, 9.999999776e-03f, 5.623413250e-03f, 3.162277862e-03f, 1.778279431e-03f,
  1.000000047e-03f, 5.623413017e-04f, 3.162277862e-04f, 1.778279402e-04f};

#ifndef PROBE_SEL
#define PROBE_SEL 0
#endif
extern __shared__ __attribute__((aligned(16))) unsigned char g_smem_all[];
#define g_smem_st (g_smem_all + SMEM_ST)
#define TSTART(sel) unsigned long long _ts##sel = 0; if (PROBE_SEL == sel) _ts##sel = __builtin_amdgcn_s_memrealtime();
#define TSTOP(sel) if (PROBE_SEL == sel) { const unsigned _dt = (unsigned)(__builtin_amdgcn_s_memrealtime() - _ts##sel); if (threadIdx.x == 0) ((volatile LAS unsigned*)(g_smem_st))[2] += _dt; }
DI unsigned cvtpk(float lo, float hi) { f32x2_t v = {lo, hi}; bf16x2_t b = __builtin_convertvector(v, bf16x2_t); return __builtin_bit_cast(unsigned, b); }
DI u32x2 pack4(f32x4 v, float sc);
DI float bflo(unsigned u) { return __uint_as_float(u << 16); }
DI float bfhi(unsigned u) { return __uint_as_float(u & 0xffff0000u); }
DI u16 f2bf(float f) { return (u16)(cvtpk(f, 0.f) & 0xffffu); }
DI float fexp2(float x) { return __builtin_amdgcn_exp2f(x); }
DI float flog2(float x) { return __builtin_amdgcn_logf(x); }
DI float frcp(float x) { return __builtin_amdgcn_rcpf(x); }
DI float frsq(float x) { return __builtin_amdgcn_rsqf(x); }
DI int otid() { int t = threadIdx.x; asm volatile("" : "+v"(t)); return t; }
DI void glds16(const void* gsrc, unsigned lds_dst) { unsigned keep;
  asm volatile("s_mov_b32 %0, m0\n\ts_mov_b32 m0, %2\n\ts_nop 0\n\tglobal_load_lds_dwordx4 %1, off\n\ts_mov_b32 m0, %0" : "=&s"(keep) : "v"(gsrc), "s"(lds_dst) : "memory"); }
DI size_t tix(int t, int c)  { return ((size_t)((t >> 7) * 32 + (c >> 5)) * 128 + (t & 127)) * 32 + (c & 31); }
DI size_t tixp(int t, int c) { return ((size_t)((t >> 7) * 8 + (c >> 5)) * 128 + (t & 127)) * 32 + (c & 31); }
DI size_t tixq(int t, int c) { return ((size_t)((t >> 7) * 20 + (c >> 5)) * 128 + (t & 127)) * 32 + (c & 31); }
DI int crow(int i, int h) { return (i & 3) + 8 * (i >> 2) + 4 * h; }
DI f32x16 mfma32(bf16x8 a, bf16x8 b, f32x16 c) { return __builtin_amdgcn_mfma_f32_32x32x16_bf16(a, b, c, 0, 0, 0); }
DI f32x4 mfma16(bf16x8 a, bf16x8 b, f32x4 c) { return __builtin_amdgcn_mfma_f32_16x16x32_bf16(a, b, c, 0, 0, 0); }
DI float pair_max(float x) { auto rr = __builtin_amdgcn_permlane32_swap(__float_as_uint(x), __float_as_uint(x), false, false); return fmaxf(__uint_as_float(rr[0]), __uint_as_float(rr[1])); }
DI float pair_sum(float x) { auto rr = __builtin_amdgcn_permlane32_swap(__float_as_uint(x), __float_as_uint(x), false, false); return __uint_as_float(rr[0]) + __uint_as_float(rr[1]); }
DI float pair_other(float x, int h) { auto rr = __builtin_amdgcn_permlane32_swap(__float_as_uint(x), __float_as_uint(x), false, false); return h ? __uint_as_float(rr[0]) : __uint_as_float(rr[1]); }
DI float silu_mul(float o, float g) { return o * g * frcp(1.f + fexp2(-g * LOG2E)); }

#define XB_TMO      128
#define XB_XCNT(j)  (256  + 64 * (j))
#define XB_XSUB(j)  (1280 + 64 * (j))
#define XB_XGEN(j)  (2304 + 64 * (j))
#define XB_TOP      3328
#define XB_TOPGEN   3392
#define XCD_BAR_WORDS 3456
#define XB_SPIN_CAP (1u << 20)
DI unsigned xb_ld(unsigned* p)              { return __hip_atomic_load(p, __ATOMIC_RELAXED, __HIP_MEMORY_SCOPE_AGENT); }
DI unsigned xb_add(unsigned* p, unsigned v) { return __hip_atomic_fetch_add(p, v, __ATOMIC_RELAXED, __HIP_MEMORY_SCOPE_AGENT); }
DI unsigned xb_xcc_id() { return (unsigned)__builtin_amdgcn_s_getreg((3 << 11) | 20) & 0xFu; }
#define XB_SPIN(cond, bar) do { unsigned _sp = 0; while (cond) { __builtin_amdgcn_s_sleep(1); \
    if ((++_sp & 255u) == 0u) { if (xb_ld(&(bar)[XB_TMO])) break; if (_sp > XB_SPIN_CAP) { atomicAdd(&(bar)[XB_TMO], 1u); break; } } } } while (0)
struct XcdBarrier { unsigned* bar; unsigned x; volatile LAS unsigned* st; };
DI XcdBarrier xcd_barrier_post(unsigned* bar, volatile LAS unsigned* st) {
  XcdBarrier b; b.bar = bar; b.x = xb_xcc_id(); b.st = st;
  if (threadIdx.x == 0) (void)xb_add(&bar[XB_XCNT(b.x)], 1u);
  return b;
}
DI void xcd_barrier_complete(unsigned* bar, unsigned x, unsigned& nloc, unsigned& nx) {
  const unsigned G = gridDim.x * gridDim.y * gridDim.z;
  unsigned sum, cnt, mine, sp = 0u;
  for (;;) {
    sum = 0u; cnt = 0u; mine = 0u;
#pragma unroll
    for (unsigned j = 0; j < 16; ++j) { const unsigned c = xb_ld(&bar[XB_XCNT(j)]); sum += c; cnt += (c > 0u) ? 1u : 0u; mine = (j == x) ? c : mine; }
    if (sum == G) break;
    __builtin_amdgcn_s_sleep(1);
    if ((++sp & 255u) == 0u) { if (xb_ld(&bar[XB_TMO])) break; if (sp > XB_SPIN_CAP) { atomicAdd(&bar[XB_TMO], 1u); break; } }
  }
  nloc = mine > 0u ? mine : 1u; nx = cnt > 0u ? cnt : 1u;
}
DI void xcd_barrier(const XcdBarrier& b) {
  TSTART(3)
  asm volatile("s_waitcnt vmcnt(0)" ::: "memory");
  __syncthreads();
  if (threadIdx.x == 0) {
    unsigned* bar = b.bar;
    __builtin_amdgcn_s_waitcnt(0);
    unsigned nloc = b.st[0], nx = b.st[1];
    if (nloc == 0u) { xcd_barrier_complete(bar, b.x, nloc, nx); b.st[0] = nloc; b.st[1] = nx; }
    const unsigned old = xb_add(&bar[XB_XSUB(b.x)], 1u);
    const unsigned gen = old / nloc;
    if (old + 1u == (gen + 1u) * nloc) {
      __builtin_amdgcn_fence(__ATOMIC_RELEASE, "agent");
      asm volatile("s_waitcnt vmcnt(0)" ::: "memory");
      const unsigned og = xb_add(&bar[XB_TOP], 1u);
      const unsigned tg = og / nx;
      if (og + 1u == (tg + 1u) * nx) xb_add(&bar[XB_TOPGEN], 1u);
      else XB_SPIN(xb_ld(&bar[XB_TOPGEN]) == tg, bar);
      __builtin_amdgcn_fence(__ATOMIC_ACQUIRE, "agent");
      xb_add(&bar[XB_XGEN(b.x)], 1u);
      asm volatile("s_waitcnt vmcnt(0)" ::: "memory");
    } else {
      XB_SPIN(xb_ld(&bar[XB_XGEN(b.x)]) == gen, bar);
      __builtin_amdgcn_fence(__ATOMIC_ACQUIRE, "agent");
      asm volatile("s_waitcnt vmcnt(0)" ::: "memory");
    }
  }
  __syncthreads();
  TSTOP(3)
}

struct Job { const float* src; const float* gain; u16* dst; int K, ldsrc, Ndst, mode, nscale, bn; };
DI Job get_job(const Params& P, int j) {
  u16* W = (u16*)(P.ws + WS_W);
  Job b; b.mode = 0; b.nscale = 0; b.gain = nullptr;
  if (j < 8) {
    const int l = j >> 2, q = j & 3; u16* base = W + l * W_MLA_SZ;
    if (q == 0)      { b.src = P.mla_w_in + (size_t)l * 1024 * 1696; b.gain = P.mla_ln_g + l * 1024; b.dst = base; b.K = 1024; b.ldsrc = 1696; b.Ndst = 1792; b.mode = 1; }
    else if (q == 1) { b.src = P.mla_w_q_up + (size_t)l * 384 * 1536; b.gain = P.mla_q_norm_g + l * 384; b.dst = base + W_MLA_Q; b.K = 384; b.ldsrc = 1536; b.Ndst = 1536; }
    else if (q == 2) { b.src = P.mla_w_kv_up + (size_t)l * 256 * 2048; b.gain = P.mla_kv_norm_g + l * 256; b.dst = base + W_MLA_KV; b.K = 256; b.ldsrc = 2048; b.Ndst = 2048; }
    else             { b.src = P.mla_w_out + (size_t)l * 1024 * 1024; b.dst = base + W_MLA_OUT; b.K = 1024; b.ldsrc = 1024; b.Ndst = 1024; }
  } else if (j == 8)  { b.src = P.sb_w_in; b.gain = P.sb_ln_g; b.dst = W + W_SB0; b.K = 1024; b.ldsrc = 2048; b.Ndst = 2048; b.nscale = 1024; }
  else if (j == 9)    { b.src = P.w_kv_shared; b.gain = P.kv_ln_g; b.dst = W + W_SB0 + (size_t)2048 * KP1024; b.K = 1024; b.ldsrc = 2048; b.Ndst = 2048; }
  else if (j == 10)   { b.src = P.sb_w_out; b.dst = W + W_SB0_OUT; b.K = 1024; b.ldsrc = 1024; b.Ndst = 1024; }
  else if (j == 11)   { b.src = P.sb_w_in + (size_t)1024 * 2048; b.gain = P.sb_ln_g + 1024; b.dst = W + W_SB1; b.K = 1024; b.ldsrc = 2048; b.Ndst = 2048; b.nscale = 1024; }
  else if (j == 12)   { b.src = P.sb_w_out + (size_t)1024 * 1024; b.dst = W + W_SB1_OUT; b.K = 1024; b.ldsrc = 1024; b.Ndst = 1024; }
  else {
    const int i = (j - 13) >> 1, q = (j - 13) & 1; u16* base = W + W_PLE + i * W_PLE_SZ;
    if (q == 0) { b.src = P.ple_w_gate + (size_t)i * 1024 * 1024; b.dst = base; b.K = 1024; b.ldsrc = 1024; b.Ndst = 1024; }
    else        { b.src = P.ple_w_proj + (size_t)i * 256 * 1024; b.dst = base + (size_t)1024 * KP1024; b.K = 256; b.ldsrc = 1024; b.Ndst = 1024; }
  }
  b.bn = (j >= 13) ? 128 : 256;
  return b;
}
constexpr int NJOBS = 21;
__device__ const int c_job_start[22] = {0, 448, 592, 720, 976, 1424, 1568, 1696, 1952, 2464, 2976, 3232, 3744, 4000, 4256, 4320, 4576, 4640, 4896, 4960, 5216, 5280};

DI void phase_prep(const Params& P, unsigned char* smem, int v, int G) {
  const int tid = otid();
  {
    float* cosT = (float*)(P.ws + WS_COS); float* sinT = (float*)(P.ws + WS_SIN);
    for (int e = v * NTHR + tid; e < T_ * 16; e += G * NTHR) {
      const int t = e >> 4, i = e & 15;
      const float ang = (float)P.pos[t] * c_inv_freq[i];
      const double rev = (double)ang * 0.15915494309189535;
      const float fr = (float)(rev - __builtin_rint(rev));
      cosT[e] = __builtin_amdgcn_cosf(fr); sinT[e] = __builtin_amdgcn_sinf(fr);
    }
  }
  {
    u16* XB = (u16*)(P.ws + WS_XB);
    const int GS = G * NTHR;
    for (int e0 = (v * NTHR + tid); e0 < T_ * 1024 / 4; e0 += 8 * GS) {
      f32x4 xv[8];
#pragma unroll
      for (int q = 0; q < 8; ++q) { const int e = e0 + q * GS; if (e < T_ * 1024 / 4) xv[q] = __builtin_nontemporal_load((const f32x4*)(P.x + (size_t)e * 4)); }
#pragma unroll
      for (int q = 0; q < 8; ++q) { const int e = e0 + q * GS; if (e < T_ * 1024 / 4) *(u32x2*)(XB + tix(e >> 8, (e & 255) * 4)) = pack4(xv[q], 1.f); }
    }
  }
}

struct PrepTile { Job jb; int n0, k0; };
DI PrepTile prep_tile_info(const Params& P, int g, int jlo) {
  int j = jlo;
#pragma unroll 1
  while (g >= c_job_start[j + 1]) ++j;
  PrepTile t; t.jb = get_job(P, j);
  const int nkt = t.jb.K >> 5;
  const int tIdx = g - c_job_start[j];
  const int nb = tIdx / nkt, kb = tIdx - nb * nkt;
  t.n0 = nb * 128; t.k0 = kb * 32;
  return t;
}
DI void prep_tile_load(const PrepTile& t, int tid, f32x4 (&vals)[4]) {
  const int np = t.n0 + (tid & 31) * 4;
  int sc = np; bool zero = false;
  if (t.jb.mode == 1) { if (np < 640) sc = np; else if (np < 1664) sc = np + 32; else if (np < 1696) sc = np - 1024; else { sc = 0; zero = true; } }
  const float colscale = (np < t.jb.nscale) ? 0.125f * LOG2E : 1.f;
#pragma unroll
  for (int jj = 0; jj < 4; ++jj) {
    const int kk = (tid >> 5) + 8 * jj;
    f32x4 val = {0.f, 0.f, 0.f, 0.f};
    if (!zero) {
      val = __builtin_nontemporal_load((const f32x4*)(t.jb.src + (size_t)(t.k0 + kk) * t.jb.ldsrc + sc));
      float sc2 = colscale; if (t.jb.gain) sc2 *= t.jb.gain[t.k0 + kk];
      val *= sc2;
    }
    vals[jj] = val;
  }
}
DI void prep_tile_lds(int tid, const f32x4 (&vals)[4], float* tile) {
#pragma unroll
  for (int jj = 0; jj < 4; ++jj) *(f32x4*)(tile + ((tid >> 5) + 8 * jj) * 132 + (tid & 31) * 4) = vals[jj];
}
DI void prep_tile_store(const PrepTile& t, int tid, const float* tile) {
  const int nl = tid >> 1, kh = (tid & 1) * 16;
  const int n = t.n0 + nl, ntl = n / t.jb.bn, rn = n - ntl * t.jb.bn;
  u16* dst = t.jb.dst + ((size_t)(ntl * (t.jb.K >> 5) + (t.k0 >> 5)) * t.jb.bn + rn) * 32 + kh;
#pragma unroll
  for (int q = 0; q < 2; ++q) {
    u32x4 o;
#pragma unroll
    for (int e = 0; e < 4; ++e) o[e] = cvtpk(tile[(kh + q * 8 + 2 * e) * 132 + nl], tile[(kh + q * 8 + 2 * e + 1) * 132 + nl]);
    *(u32x4*)(dst + q * 8) = o;
  }
}
DI void prep_jobs(const Params& P, unsigned char* smem, int v, int G, int jlo, int jhi) {
  const int tid = otid();
  float* tileA = (float*)smem;
  float* tileB = tileA + 32 * 132;
  const int gend = c_job_start[jhi];
  for (int g = c_job_start[jlo] + v; g < gend; g += 2 * G) {
    const bool hasB = (g + G) < gend;
    const PrepTile ta = prep_tile_info(P, g, jlo);
    const PrepTile tb = prep_tile_info(P, hasB ? g + G : g, jlo);
    f32x4 va[4], vb[4];
    prep_tile_load(ta, tid, va);
    if (hasB) prep_tile_load(tb, tid, vb);
    __syncthreads();
    prep_tile_lds(tid, va, tileA);
    if (hasB) prep_tile_lds(tid, vb, tileB);
    __syncthreads();
    prep_tile_store(ta, tid, tileA);
    if (hasB) prep_tile_store(tb, tid, tileB);
  }
}

template <int NB, bool AF32, bool SUMSQ>
DI void gemm_main(const void* __restrict__ Ap, int lda, const u16* __restrict__ Bp, int ldb, int K,
                  f32x16 (&acc)[2][NB], u16* smem, float* rowss, float invK) {
  static_assert(!AF32, "operands are bf16 tiled images");
  constexpr int BN = 64 * NB, STG = (128 + BN) * 64, NI = STG / 4096;
  static_assert(3 * STG <= SMEM_MAIN, "gemm ring");
  const int tid = otid(), lane = tid & 63, w = tid >> 6, wm = w >> 1, wn = w & 1, r = lane & 31, h = lane >> 5;
  unsigned char* smb = (unsigned char*)smem;
  const unsigned lds0 = (unsigned)(__UINTPTR_TYPE__)(LAS unsigned char*)smb;
  const int nk = K >> 5;
  const u16* gp[NI]; int adv[NI]; unsigned pdst[NI];
#pragma unroll
  for (int j = 0; j < NI; ++j) {
    const int q = __builtin_amdgcn_readfirstlane(w * NI + j);
    pdst[j] = (unsigned)q * 1024u;
    const bool isA = q < 8;
    const int sl = (isA ? q : q - 8) * 64 + lane, row = sl >> 2, pc = sl & 3, c = pc ^ ((row >> 2) & 3);
    gp[j] = (isA ? (const u16*)Ap : Bp) + row * 32 + c * 8;
    adv[j] = isA ? 128 * 32 : BN * 32;
  }
#define G_ISSUE(kt, st) do { \
    _Pragma("unroll") for (int j = 0; j < NI; ++j) glds16(gp[j] + (size_t)(kt) * adv[j], lds0 + (unsigned)(st) * STG + pdst[j]); } while (0)
  float ss[4] = {0.f, 0.f, 0.f, 0.f};
  const int r16 = lane & 15, quad = lane >> 4;
  const int co16 = (quad ^ ((r16 >> 2) & 3)) * 16;
  const int aoff = (wm * 64 + r16) * 64, boff = 8192 + (wn * 32 * NB + r16) * 64;

  TSTART(1)
  asm volatile("s_waitcnt vmcnt(0)" ::: "memory");
  __syncthreads();
  G_ISSUE(0, 0);
  G_ISSUE(1, 1);
  int st_cur = 0, st_nxt = 2;
#pragma unroll 2
  for (int kt = 0; kt < nk; ++kt) {
    asm volatile("s_waitcnt vmcnt(%0) lgkmcnt(0)" :: "n"(NI) : "memory");
    __builtin_amdgcn_s_barrier();
    const unsigned char* stg = smb + st_cur * STG;
    const int st_iss = st_nxt;
    st_cur = (st_cur == 2) ? 0 : st_cur + 1; st_nxt = (st_nxt == 2) ? 0 : st_nxt + 1;
    {
      bf16x8 af2[2][2]; bf16x8 bf2[NB][2];
#pragma unroll
      for (int mb = 0; mb < 2; ++mb)
#pragma unroll
        for (int ms = 0; ms < 2; ++ms) af2[mb][ms] = *(const bf16x8*)(stg + aoff + (mb * 32 + ms * 16) * 64 + co16);
#pragma unroll
      for (int nb = 0; nb < NB; ++nb)
#pragma unroll
        for (int ns = 0; ns < 2; ++ns) bf2[nb][ns] = *(const bf16x8*)(stg + boff + (nb * 32 + ns * 16) * 64 + co16);
      { const int kn = min(kt + 2, nk - 1); G_ISSUE(kn, st_iss); }
      __builtin_amdgcn_s_setprio(1);
#pragma unroll
      for (int mb = 0; mb < 2; ++mb)
#pragma unroll
        for (int nb = 0; nb < NB; ++nb)
#pragma unroll
          for (int ms = 0; ms < 2; ++ms)
#pragma unroll
            for (int ns = 0; ns < 2; ++ns) {
              f32x4 c4;
#pragma unroll
              for (int j = 0; j < 4; ++j) c4[j] = acc[mb][nb][(ms * 2 + ns) * 4 + j];
              c4 = mfma16(bf2[nb][ns], af2[mb][ms], c4);
#pragma unroll
              for (int j = 0; j < 4; ++j) acc[mb][nb][(ms * 2 + ns) * 4 + j] = c4[j];
            }
      __builtin_amdgcn_s_setprio(0);
      if constexpr (SUMSQ) {
#define SS_ACC(MB) do { _Pragma("unroll") for (int ms = 0; ms < 2; ++ms) { const u32x4 u = __builtin_bit_cast(u32x4, af2[MB][ms]); \
          _Pragma("unroll") for (int q = 0; q < 4; ++q) { const float lo = bflo(u[q]), hi = bfhi(u[q]); ss[ms] += lo * lo + hi * hi; } } } while (0)
        if (wn == 0) SS_ACC(0); else SS_ACC(1);
#undef SS_ACC
      }
    }
  }
#undef G_ISSUE
  asm volatile("s_waitcnt vmcnt(0)" ::: "memory");
  __syncthreads();
  TSTOP(1)
  if constexpr (SUMSQ) {
#pragma unroll
    for (int ms = 0; ms < 2; ++ms) {
      float tot = ss[ms];
      tot += __shfl_xor(tot, 16); tot += __shfl_xor(tot, 32);
      if (quad == 0) rowss[wm * 64 + wn * 32 + ms * 16 + r16] = frsq(tot * invK + EPS);
    }
    __syncthreads();
  }
}

template <int NB>
DI void acc_zero(f32x16 (&acc)[2][NB]) {
#pragma unroll
  for (int a = 0; a < 2; ++a)
#pragma unroll
    for (int b = 0; b < NB; ++b)
#pragma unroll
      for (int i = 0; i < 16; ++i) acc[a][b][i] = 0.f;
}

template <int NB>
DI void acc_to_cs(const f32x16 (&acc)[2][NB], float* Cs, int p) {
  const int tid = otid(), lane = tid & 63, w = tid >> 6, wm = w >> 1, wn = w & 1, r16 = lane & 15, quad = lane >> 4;
  float* base = Cs + (wm * 64 + r16) * CS_LD + wn * 64 + quad * 4;
#pragma unroll
  for (int mb = 0; mb < 2; ++mb)
#pragma unroll
    for (int nbl = 0; nbl < 2; ++nbl)
#pragma unroll
      for (int ms = 0; ms < 2; ++ms)
#pragma unroll
        for (int ns = 0; ns < 2; ++ns) {
          f32x4 c4;
#pragma unroll
          for (int j = 0; j < 4; ++j) c4[j] = acc[mb][2 * p + nbl][(ms * 2 + ns) * 4 + j];
          *(f32x4*)(base + (mb * 32 + ms * 16) * CS_LD + nbl * 32 + ns * 16) = c4;
        }
}
#define EPI_ROWS(NBV, PV, ...) do { const int _t = otid(); \
    _Pragma("unroll 2") for (int _ps = 0; _ps < 8; ++_ps) { const int m = _ps * 16 + (_t >> 4); \
      _Pragma("unroll") for (int _hf = 0; _hf < 2; ++_hf) { const int n = _hf * 64 + (_t & 15) * 4; \
        const int gc = ((NBV) == 4) ? (_hf * 128 + (PV) * 64 + (_t & 15) * 4) : n; (void)gc; \
        f32x4 val = *(const f32x4*)(Cs + m * CS_LD + n); __VA_ARGS__ } } } while (0)
#define EPI_TILE(NBV, ACC, ...) do { \
    _Pragma("unroll") for (int _p = 0; _p < (NBV) / 2; ++_p) { \
      if (_p) __syncthreads(); \
      acc_to_cs<NBV>(ACC, Cs, _p); \
      __syncthreads(); \
      EPI_ROWS(NBV, _p, __VA_ARGS__); } } while (0)
#define EPI_TILE_RES(NBV, ACC, RES, T0, CBASE, ...) do { \
    _Pragma("unroll") for (int _p = 0; _p < (NBV) / 2; ++_p) { \
      f32x4 _xr[16]; { const int _t = otid(); \
        _Pragma("unroll") for (int _ps = 0; _ps < 8; ++_ps) _Pragma("unroll") for (int _hf = 0; _hf < 2; ++_hf) { \
          const int m = _ps * 16 + (_t >> 4); const int gc = ((NBV) == 4) ? (_hf * 128 + _p * 64 + (_t & 15) * 4) : (_hf * 64 + (_t & 15) * 4); \
          _xr[_ps * 2 + _hf] = *(const f32x4*)((RES) + (size_t)((T0) + m) * 1024 + (CBASE) + gc); } } \
      if (_p) __syncthreads(); \
      acc_to_cs<NBV>(ACC, Cs, _p); \
      __syncthreads(); \
      { const int _t = otid(); \
        _Pragma("unroll") for (int _ps = 0; _ps < 8; ++_ps) _Pragma("unroll") for (int _hf = 0; _hf < 2; ++_hf) { \
          const int m = _ps * 16 + (_t >> 4); const int n = _hf * 64 + (_t & 15) * 4; \
          const int gc = ((NBV) == 4) ? (_hf * 128 + _p * 64 + (_t & 15) * 4) : n; \
          const f32x4 val = *(const f32x4*)(Cs + m * CS_LD + n); const f32x4 res = _xr[_ps * 2 + _hf]; __VA_ARGS__ } } } } while (0)
DI u32x2 pack4(f32x4 v, float sc) { u32x2 o; o[0] = cvtpk(v[0] * sc, v[1] * sc); o[1] = cvtpk(v[2] * sc, v[3] * sc); return o; }

DI void store_vt(const float* Cs, const float* rstd, u16* Vt, int bh0, int hstride, int s0) {
  for (int idx = otid(); idx < 128 * 4; idx += NTHR) {
    const int cc = idx & 127, mq = idx >> 7;
    const float* src = Cs + (mq * 32) * CS_LD + cc;
    const float* rsp = rstd + mq * 32;
    const int sq = s0 + mq * 32;
    u16* dst = Vt + (((size_t)(bh0 + (cc >> 6) * hstride) * 32 + (sq >> 6)) * 64 + (cc & 63)) * 64 + (sq & 63);
#pragma unroll
    for (int q = 0; q < 4; ++q) {
      u32x4 o;
#pragma unroll
      for (int e = 0; e < 4; ++e) {
        const int tk = (q >> 1) * 16 + (q & 1) * 4 + (e >> 1) * 8 + (e & 1) * 2;
        o[e] = cvtpk(src[tk * CS_LD] * rsp[tk], src[(tk + 1) * CS_LD] * rsp[tk + 1]);
      }
      *(u32x4*)(dst + q * 8) = o;
    }
  }
}

DI void phase_mla_in(const Params& P, int l, unsigned char* smem, int v, int G) {
  u16* sm = (u16*)smem; float* rowss = (float*)(smem + SMEM_ROWSS); float* Cs = (float*)smem;
  const u16* Wt = (const u16*)(P.ws + WS_W) + l * W_MLA_SZ;
  const u16* XB = (const u16*)(P.ws + WS_XB);
  u16* CQ = (u16*)(P.ws + WS_CQ); u16* GATE = (u16*)(P.ws + WS_GATE); u16* KROPE = (u16*)(P.ws + WS_KROPE);
  for (int tile = v; tile < 128 * 7; tile += G) {
    const int mt = tile / 7, nt = tile - mt * 7, t0 = mt * 128;
    f32x16 acc[2][4]; acc_zero<4>(acc);
    gemm_main<4, false, true>(XB + tix(t0, 0), 0, Wt + (size_t)nt * 256 * KP1024, KP1024, 1024, acc, sm, rowss, 1.f / 1024.f);
    EPI_TILE(4, acc, {
      const int col = nt * 256 + gc; const u32x2 o = pack4(val, rowss[m]);
      if (col < 640) *(u32x2*)(CQ + tixq(t0 + m, col)) = o;
      else if (col < 1664) *(u32x2*)(GATE + tix(t0 + m, col - 640)) = o;
      else if (col < 1696) *(u32x2*)(KROPE + (size_t)(t0 + m) * 32 + col - 1664) = o; });
  }
}

DI void phase_mla_qkv(const Params& P, int l, unsigned char* smem, int v, int G) {
  u16* sm = (u16*)smem; float* rowss = (float*)(smem + SMEM_ROWSS); float* Cs = (float*)smem;
  const u16* Wt = (const u16*)(P.ws + WS_W) + l * W_MLA_SZ;
  const u16* CQ = (const u16*)(P.ws + WS_CQ); u16* QRAW = (u16*)(P.ws + WS_XA);
  const u16* KROPE = (const u16*)(P.ws + WS_KROPE);
  u16* KBUF = (u16*)(P.ws + WS_KBUF); u16* VT = (u16*)(P.ws + WS_VT);
  const float* cosT = (const float*)(P.ws + WS_COS); const float* sinT = (const float*)(P.ws + WS_SIN);
  const float* gk = P.mla_k_head_g + l * 96;
  for (int tile = v; tile < 128 * 6 + 128 * 8; tile += G) {
    f32x16 acc[2][4]; acc_zero<4>(acc);
    if (tile < 128 * 6) {
      const int mt = tile / 6, nt = tile - mt * 6, t0 = mt * 128;
      gemm_main<4, false, true>(CQ + tixq(t0, 0), 0, Wt + W_MLA_Q + (size_t)nt * 256 * KP384, KP384, 384, acc, sm, rowss, 1.f / 384.f);
      EPI_TILE(4, acc, { *(u32x2*)(QRAW + (size_t)(t0 + m) * LDQR + nt * 256 + gc) = pack4(val, rowss[m]); });
    } else {
      const int tk = tile - 128 * 6;
      const int mt = tk >> 3, hp = tk & 7, t0 = mt * 128;
      gemm_main<4, false, true>(CQ + tixq(t0, 384), 0, Wt + W_MLA_KV + (size_t)hp * 256 * KP256, KP256, 256, acc, sm, rowss, 1.f / 256.f);
      const int b = t0 >> 11, s0 = t0 & 2047;
      acc_to_cs<4>(acc, Cs, 0);
      __syncthreads();
      {
        const int tid = otid(), m = tid >> 1, hd = tid & 1, t = t0 + m;
        const float rsk = rowss[m];
        const float* crow_p = Cs + m * CS_LD + hd * 64;
        float x1[16], x2[16];
        {
          const u16* kr = KROPE + (size_t)t * 32;
          const u32x4 r0 = *(const u32x4*)kr, r1 = *(const u32x4*)(kr + 8), r2 = *(const u32x4*)(kr + 16), r3 = *(const u32x4*)(kr + 24);
#pragma unroll
          for (int q = 0; q < 4; ++q) {
            x1[2 * q] = bflo(r0[q]); x1[2 * q + 1] = bfhi(r0[q]); x1[8 + 2 * q] = bflo(r1[q]); x1[8 + 2 * q + 1] = bfhi(r1[q]);
            x2[2 * q] = bflo(r2[q]); x2[2 * q + 1] = bfhi(r2[q]); x2[8 + 2 * q] = bflo(r3[q]); x2[8 + 2 * q + 1] = bfhi(r3[q]);
          }
        }
        float ssq = 0.f;
#pragma unroll
        for (int q = 0; q < 16; ++q) { const f32x4 a = *(const f32x4*)(crow_p + q * 4) * rsk; ssq += a[0] * a[0] + a[1] * a[1] + a[2] * a[2] + a[3] * a[3]; }
#pragma unroll
        for (int q = 0; q < 16; ++q) ssq += x1[q] * x1[q] + x2[q] * x2[q];
        const float rs = frsq(ssq * (1.f / 96.f) + EPS);
        u16* kdst = KBUF + ((size_t)(b * 16 + 2 * hp + hd) * S_ + s0 + m) * 96;
        const float rs2 = rs * rsk;
#pragma unroll
        for (int q = 0; q < 8; ++q) {
          const f32x4 a0 = *(const f32x4*)(crow_p + q * 8), a1 = *(const f32x4*)(crow_p + q * 8 + 4);
          const int d = q * 8;
          u32x4 o;
          o[0] = cvtpk(a0[0] * rs2 * gk[d], a0[1] * rs2 * gk[d + 1]);
          o[1] = cvtpk(a0[2] * rs2 * gk[d + 2], a0[3] * rs2 * gk[d + 3]);
          o[2] = cvtpk(a1[0] * rs2 * gk[d + 4], a1[1] * rs2 * gk[d + 5]);
          o[3] = cvtpk(a1[2] * rs2 * gk[d + 6], a1[3] * rs2 * gk[d + 7]);
          *(u32x4*)(kdst + d) = o;
        }
#pragma unroll
        for (int q = 0; q < 16; ++q) {
          const float a1 = x1[q] * rs * gk[64 + q], a2 = x2[q] * rs * gk[80 + q];
          const float c = cosT[t * 16 + q], s = sinT[t * 16 + q];
          x1[q] = a1 * c - a2 * s; x2[q] = a2 * c + a1 * s;
        }
#pragma unroll
        for (int q = 0; q < 2; ++q) {
          u32x4 w1, w2;
#pragma unroll
          for (int e = 0; e < 4; ++e) { w1[e] = cvtpk(x1[q * 8 + 2 * e], x1[q * 8 + 2 * e + 1]); w2[e] = cvtpk(x2[q * 8 + 2 * e], x2[q * 8 + 2 * e + 1]); }
          *(u32x4*)(kdst + 64 + q * 8) = w1;
          *(u32x4*)(kdst + 80 + q * 8) = w2;
        }
      }
      __syncthreads();
      acc_to_cs<4>(acc, Cs, 1);
      __syncthreads();
      store_vt(Cs, rowss, VT, b * 16 + 2 * hp, 1, s0);
    }
  }
}

template <bool MLA>
DI void attn_item(const Params& P, int l, int bh, int qb, u16* sm) {
  constexpr int DK = MLA ? 96 : 64, KSTR = DK + 8, NKS = DK / 16;
  constexpr int KROWB = DK * 2, KBYTES = 64 * KROWB, STG = KBYTES + 8192, NI = STG / 4096;
  constexpr int QOFF = MLA ? 2 * STG : 3 * STG;
  static_assert(QOFF + 128 * KSTR * 2 <= SMEM_MAIN, "attention LDS map");
  unsigned char* smb = (unsigned char*)sm;
  u16* Qs = (u16*)(smb + QOFF);
  const int tid = otid(), lane = tid & 63, w = tid >> 6, r = lane & 31, h = lane >> 5;
  const int b = bh >> 4, hh = bh & 15;
  const int tq0 = b * S_ + qb * 128;
  const u16* Kg = (const u16*)(P.ws + WS_KBUF) + (size_t)bh * S_ * DK;
  const u16* Vg = (const u16*)(P.ws + WS_VT) + (size_t)bh * 64 * S_;
  u16* GATE = (u16*)(P.ws + WS_GATE);
  const int nkt = 2 * qb + 2;
  const unsigned lds0 = (unsigned)(__UINTPTR_TYPE__)(LAS unsigned char*)smb;
  const u16* gp[NI]; int adv[NI]; unsigned pdst[NI];
#pragma unroll
  for (int j = 0; j < NI; ++j) {
    const int q = __builtin_amdgcn_readfirstlane(w * NI + j);
    pdst[j] = (unsigned)q * 1024u;
    if (q < KBYTES / 1024) {
      const int sl = q * 64 + lane, key = sl / (DK / 8), pc = sl - key * (DK / 8), c = pc ^ ((key >> 2) & 3);
      gp[j] = Kg + key * DK + c * 8; adv[j] = 64 * DK;
    } else {
      const int sl = (q - KBYTES / 1024) * 64 + lane, d = sl >> 3, pc = sl & 7, c = pc ^ ((d >> 1) & 7);
      gp[j] = Vg + d * 64 + c * 8; adv[j] = 64 * 64;
    }
  }
#define KV_ISSUE(kt, st) do { \
    _Pragma("unroll") for (int j = 0; j < NI; ++j) glds16(gp[j] + (size_t)(kt) * adv[j], lds0 + (unsigned)(st) * STG + pdst[j]); } while (0)

  __syncthreads();
  KV_ISSUE(MLA ? 0 : nkt - 1, 0);
  KV_ISSUE(MLA ? 1 : nkt - 2, 1);
  if constexpr (MLA) {
    const u16* QRAW = (const u16*)(P.ws + WS_XA);
    const float* gq = P.mla_q_head_g + l * 96;
    const float* cosT = (const float*)(P.ws + WS_COS); const float* sinT = (const float*)(P.ws + WS_SIN);
    const int m = tid >> 1, hf = tid & 1, t = tq0 + m;
    const u16* src = QRAW + (size_t)t * LDQR + hh * 96 + hf * 48;
    float q[48];
#pragma unroll
    for (int c = 0; c < 6; ++c) {
      const u32x4 u = *(const u32x4*)(src + c * 8);
#pragma unroll
      for (int e = 0; e < 4; ++e) { q[c * 8 + 2 * e] = bflo(u[e]); q[c * 8 + 2 * e + 1] = bfhi(u[e]); }
    }
    float ssq = 0.f;
#pragma unroll
    for (int d = 0; d < 48; ++d) ssq += q[d] * q[d];
    ssq += __shfl_xor(ssq, 1);
    const float rs = frsq(ssq * (1.f / 96.f) + EPS) * (0.10206207261596575f * LOG2E);
#pragma unroll
    for (int d = 0; d < 48; ++d) q[d] = q[d] * rs * gq[hf * 48 + d];
    if (hf) {
#pragma unroll
      for (int i4 = 0; i4 < 4; ++i4) {
        const f32x4 c4 = *(const f32x4*)(cosT + t * 16 + i4 * 4), s4 = *(const f32x4*)(sinT + t * 16 + i4 * 4);
#pragma unroll
        for (int e = 0; e < 4; ++e) {
          const int i2 = i4 * 4 + e;
          const float a1 = q[16 + i2], a2 = q[32 + i2];
          q[16 + i2] = a1 * c4[e] - a2 * s4[e]; q[32 + i2] = a2 * c4[e] + a1 * s4[e];
        }
      }
    }
    u16* qd = Qs + m * KSTR + hf * 48;
#pragma unroll
    for (int c = 0; c < 6; ++c) {
      u32x4 o;
#pragma unroll
      for (int e = 0; e < 4; ++e) o[e] = cvtpk(q[c * 8 + 2 * e], q[c * 8 + 2 * e + 1]);
      *(u32x4*)(qd + c * 8) = o;
    }
  } else {
    const u16* QSB = (const u16*)(P.ws + WS_XA);
#pragma unroll
    for (int j = 0; j < 4; ++j) {
      const int c = tid + 256 * j, row = c >> 3, c8 = c & 7;
      const u32x4 u = *(const u32x4*)(QSB + (size_t)(tq0 + row) * LDX + hh * 64 + c8 * 8);
      *(u32x4*)(Qs + row * KSTR + c8 * 8) = u;
    }
  }
  __syncthreads();
  bf16x8 qf[NKS];
#pragma unroll
  for (int s = 0; s < NKS; ++s) qf[s] = *(const bf16x8*)(Qs + (w * 32 + r) * KSTR + 16 * s + 8 * h);

  f32x16 O[2];
#pragma unroll
  for (int i = 0; i < 16; ++i) { O[0][i] = 0.f; O[1][i] = 0.f; }
  float m_run = -1e30f, lsum = 0.f, carry = 1.f;
  const f32x16 zero16 = {0.f, 0.f, 0.f, 0.f, 0.f, 0.f, 0.f, 0.f, 0.f, 0.f, 0.f, 0.f, 0.f, 0.f, 0.f, 0.f};
  const int q0 = qb * 128 + w * 32;

  int st_cur = 0, st_nxt = 2;
#pragma unroll 2
  for (int it = 0; it < nkt; ++it) {
    const int kt = MLA ? it : nkt - 1 - it;
    asm volatile("s_waitcnt vmcnt(%0) lgkmcnt(0)" :: "n"(NI) : "memory");
    __builtin_amdgcn_s_barrier();
    { const int itn = min(it + 2, nkt - 1); KV_ISSUE(MLA ? itn : nkt - 1 - itn, st_nxt); }
    const unsigned char* stg = smb + st_cur * STG;
    st_cur = (st_cur == 2) ? 0 : st_cur + 1; st_nxt = (st_nxt == 2) ? 0 : st_nxt + 1;
    const int kbase = kt * 64;
    const bool active = MLA ? (kbase <= q0 + 31) : (kbase <= q0 + 30);
    if (active) {
      const unsigned char* Kc = stg + r * KROWB;
      const unsigned char* Vc = stg + KBYTES + r * 128;
      const int swk = (r >> 2) & 3, swv = (r >> 1) & 7;
      f32x16 st[2];
      {
        bf16x8 kf[NKS][2];
#pragma unroll
        for (int s = 0; s < NKS; ++s) {
          const int ko = ((2 * s + h) ^ swk) * 16;
          kf[s][0] = *(const bf16x8*)(Kc + ko);
          kf[s][1] = *(const bf16x8*)(Kc + 32 * KROWB + ko);
        }
        __builtin_amdgcn_sched_barrier(0);
        __builtin_amdgcn_s_setprio(1);
#pragma unroll
        for (int s = 0; s < NKS; ++s) {
          st[0] = mfma32(kf[s][0], qf[s], s == 0 ? zero16 : st[0]);
          st[1] = mfma32(kf[s][1], qf[s], s == 0 ? zero16 : st[1]);
        }
        __builtin_amdgcn_s_setprio(0);
      }
      bf16x8 pf[2][2];
      if constexpr (MLA) {
        if (kbase + 63 > q0) {
#pragma unroll
          for (int kb = 0; kb < 2; ++kb)
#pragma unroll
            for (int i = 0; i < 16; ++i) { const int key = kbase + kb * 32 + crow(i, h); if (key > q0 + r) st[kb][i] = -1e30f; }
        }
        float mx = st[0][0];
#pragma unroll
        for (int i = 1; i < 16; ++i) mx = fmaxf(mx, st[0][i]);
#pragma unroll
        for (int i = 0; i < 16; ++i) mx = fmaxf(mx, st[1][i]);
        mx = pair_max(mx);
        const float mnew = fmaxf(m_run, mx);
        const float alpha = fexp2(m_run - mnew);
        m_run = mnew;
        f32x2_t ps2 = {0.f, 0.f};
        const f32x2_t mn2 = {mnew, mnew};
#pragma unroll
        for (int kb = 0; kb < 2; ++kb)
#pragma unroll
          for (int i = 0; i < 16; i += 2) {
            f32x2_t d2 = {st[kb][i], st[kb][i + 1]}; d2 -= mn2;
            f32x2_t p2 = {fexp2(d2[0]), fexp2(d2[1])};
            st[kb][i] = p2[0]; st[kb][i + 1] = p2[1]; ps2 += p2;
          }
        const float psum = ps2[0] + ps2[1];
        if (__builtin_amdgcn_ballot_w64(alpha != 1.f) != 0ull) {
          lsum *= alpha;
#pragma unroll
          for (int i = 0; i < 16; ++i) { O[0][i] *= alpha; O[1][i] *= alpha; }
        }
        lsum += psum;
      } else {
        const bool msk = (kbase + 63 >= q0);
        f32x16 L[2];
#define SB_ELEMS(MASKED) do { \
          _Pragma("unroll") for (int kb = 0; kb < 2; ++kb) _Pragma("unroll") for (int i = 0; i < 16; i += 2) { \
            const f32x2_t u2 = {fexp2(__builtin_amdgcn_fmed3f(st[kb][i], -1e30f, 80.f)), fexp2(__builtin_amdgcn_fmed3f(st[kb][i + 1], -1e30f, 80.f))}; \
            const f32x2_t w2 = u2 + 1.f; \
            f32x2_t om2 = {frcp(w2[0]), frcp(w2[1])}; \
            f32x2_t be2 = u2 * om2; \
            if (MASKED) { const int key = kbase + kb * 32 + crow(i, h); const bool v0 = key < q0 + r, v1 = key + 1 < q0 + r; \
              om2[0] = v0 ? om2[0] : 1.f; om2[1] = v1 ? om2[1] : 1.f; be2[0] = v0 ? be2[0] : 0.f; be2[1] = v1 ? be2[1] : 0.f; } \
            L[kb][i] = om2[0]; L[kb][i + 1] = om2[1]; st[kb][i] = be2[0]; st[kb][i + 1] = be2[1]; } } while (0)
        if (msk) SB_ELEMS(true); else SB_ELEMS(false);
#undef SB_ELEMS
        float Rr[2][4], Rp[2][4], E[2][4];
#pragma unroll
        for (int kb = 0; kb < 2; ++kb)
#pragma unroll
          for (int g = 0; g < 4; ++g) { Rr[kb][g] = (L[kb][4 * g] * L[kb][4 * g + 1]) * (L[kb][4 * g + 2] * L[kb][4 * g + 3]); Rp[kb][g] = pair_other(Rr[kb][g], h); }
        float run = 1.f;
#pragma unroll
        for (int idx = 7; idx >= 0; --idx) { const int kb = idx >> 2, g = idx & 3; E[kb][g] = run; run *= Rr[kb][g] * Rp[kb][g]; }
#pragma unroll
        for (int kb = 0; kb < 2; ++kb)
#pragma unroll
          for (int g = 0; g < 4; ++g) {
            const float t3 = carry * E[kb][g] * (h == 0 ? Rp[kb][g] : 1.f);
            const float t2 = t3 * L[kb][4 * g + 3];
            const float t1 = t2 * L[kb][4 * g + 2];
            const float t0 = t1 * L[kb][4 * g + 1];
            { f32x2_t a = {st[kb][4 * g + 0], st[kb][4 * g + 1]}; const f32x2_t tt = {t0, t1}; a *= tt; st[kb][4 * g + 0] = a[0]; st[kb][4 * g + 1] = a[1]; }
            { f32x2_t a = {st[kb][4 * g + 2], st[kb][4 * g + 3]}; const f32x2_t tt = {t2, t3}; a *= tt; st[kb][4 * g + 2] = a[0]; st[kb][4 * g + 3] = a[1]; }
          }
        carry *= run;
      }
#pragma unroll
      for (int kb = 0; kb < 2; ++kb)
#pragma unroll
        for (int s2 = 0; s2 < 2; ++s2) {
          u32x4 pk;
#pragma unroll
          for (int e = 0; e < 4; ++e) pk[e] = cvtpk(st[kb][8 * s2 + 2 * e], st[kb][8 * s2 + 2 * e + 1]);
          pf[kb][s2] = __builtin_bit_cast(bf16x8, pk);
        }
      {
        u32x4 vf[2][2][2];
#pragma unroll
        for (int db = 0; db < 2; ++db)
#pragma unroll
          for (int kb = 0; kb < 2; ++kb)
#pragma unroll
            for (int s2 = 0; s2 < 2; ++s2) {
              vf[db][kb][s2] = *(const u32x4*)(Vc + db * 32 * 128 + ((kb * 4 + s2 * 2 + h) ^ swv) * 16);
            }
        __builtin_amdgcn_sched_barrier(0);
        __builtin_amdgcn_s_setprio(1);
#pragma unroll
        for (int db = 0; db < 2; ++db)
#pragma unroll
          for (int kb = 0; kb < 2; ++kb)
#pragma unroll
            for (int s2 = 0; s2 < 2; ++s2) O[db] = mfma32(__builtin_bit_cast(bf16x8, vf[db][kb][s2]), pf[kb][s2], O[db]);
        __builtin_amdgcn_s_setprio(0);
      }
    }
  }
#undef KV_ISSUE
  asm volatile("s_waitcnt vmcnt(0)" ::: "memory");
  __syncthreads();
  float inv = 1.f;
  if constexpr (MLA) { const float lt = pair_sum(lsum); inv = frcp(lt); }
  float* Ob = (float*)(Qs + w * 32 * KSTR);
#pragma unroll
  for (int db = 0; db < 2; ++db) {
    __builtin_amdgcn_s_waitcnt(0xc07f);
    __builtin_amdgcn_wave_barrier();
#pragma unroll
    for (int i = 0; i < 16; ++i) Ob[r * 33 + crow(i, h)] = O[db][i] * inv;
    __builtin_amdgcn_s_waitcnt(0xc07f);
    __builtin_amdgcn_wave_barrier();
    const int qq = lane >> 1, dh = (lane & 1) * 16;
    u16* gp = GATE + tix(tq0 + w * 32 + qq, hh * 64 + db * 32 + dh);
    const u32x4 g0 = *(const u32x4*)gp, g1 = *(const u32x4*)(gp + 8);
    float ov[16];
#pragma unroll
    for (int e = 0; e < 16; ++e) ov[e] = Ob[qq * 33 + dh + e];
    u32x4 o0, o1;
#pragma unroll
    for (int e = 0; e < 4; ++e) {
      o0[e] = cvtpk(silu_mul(ov[2 * e], bflo(g0[e])), silu_mul(ov[2 * e + 1], bfhi(g0[e])));
      o1[e] = cvtpk(silu_mul(ov[8 + 2 * e], bflo(g1[e])), silu_mul(ov[8 + 2 * e + 1], bfhi(g1[e])));
    }
    *(u32x4*)gp = o0; *(u32x4*)(gp + 8) = o1;
  }
}

template <bool MLA>
DI void phase_attn(const Params& P, int l, unsigned char* smem, unsigned xcc, int ph) {
  volatile LAS unsigned* stw = (volatile LAS unsigned*)(smem + SMEM_ST);
  unsigned* ctrs = (unsigned*)(P.ws + WS_BAR) + 3520 + ph * 128;
  for (int qx = 0; qx < 8; ++qx) {
    const int xq = (int)((xcc + (unsigned)qx) & 7u);
    for (;;) {
      TSTART(4)
      if (threadIdx.x == 0) stw[3] = atomicAdd(ctrs + xq * 16, 1u);
      __syncthreads();
      const int it = (int)stw[3];
      __syncthreads();
      if (it >= 256) break;
      attn_item<MLA>(P, l, xq * 16 + (it & 15), 15 - (it >> 4), (u16*)smem);
      TSTOP(4)
    }
  }
}

DI void phase_out(const Params& P, const u16* Wout, const float* xres, int li, unsigned char* smem, int v, int G) {
  u16* sm = (u16*)smem; float* rowss = (float*)(smem + SMEM_ROWSS); float* Cs = (float*)smem;
  const u16* OG = (const u16*)(P.ws + WS_GATE); u16* XAB = (u16*)(P.ws + WS_XA);
  {
    const float* pin = P.p + (size_t)li * T_ * 256; u16* PB = (u16*)(P.ws + WS_PB);
    const int tid = otid(), GS = G * NTHR;
    for (int e0 = v * NTHR + tid; e0 < T_ * 256 / 4; e0 += 8 * GS) {
      f32x4 xv[8];
#pragma unroll
      for (int q = 0; q < 8; ++q) { const int e = e0 + q * GS; if (e < T_ * 256 / 4) xv[q] = __builtin_nontemporal_load((const f32x4*)(pin + (size_t)e * 4)); }
#pragma unroll
      for (int q = 0; q < 8; ++q) { const int e = e0 + q * GS; if (e < T_ * 256 / 4) *(u32x2*)(PB + tixp(e >> 6, (e & 63) * 4)) = pack4(xv[q], 1.f); }
    }
  }
  for (int tile = v; tile < 128 * 4; tile += G) {
    const int mt = tile >> 2, nt = tile & 3, t0 = mt * 128;
    f32x16 acc[2][4]; acc_zero<4>(acc);
    gemm_main<4, false, false>(OG + tix(t0, 0), 0, Wout + (size_t)nt * 256 * KP1024, KP1024, 1024, acc, sm, rowss, 0.f);
    EPI_TILE_RES(4, acc, xres, t0, nt * 256, { const size_t o = (size_t)(t0 + m) * 1024 + nt * 256 + gc;
                       const f32x4 xn = res + val;
                       *(f32x4*)(P.out + o) = xn; *(u32x2*)(XAB + tix(t0 + m, nt * 256 + gc)) = pack4(xn, 1.f); });
  }
}

DI void phase_ple(const Params& P, int li, unsigned char* smem, int v, int G) {
  u16* sm = (u16*)smem; float* rowss = (float*)(smem + SMEM_ROWSS); float* Cs = (float*)smem;
  const u16* XAB = (const u16*)(P.ws + WS_XA); u16* XB = (u16*)(P.ws + WS_XB);
  const u16* Wg = (const u16*)(P.ws + WS_W) + W_PLE + li * W_PLE_SZ; const u16* Wp = Wg + (size_t)1024 * KP1024;
  const u16* PB = (const u16*)(P.ws + WS_PB);
  for (int tile = v; tile < 128 * 8; tile += G) {
    const int mt = tile >> 3, nt = tile & 7, t0 = mt * 128;
    f32x16 acc[2][2]; acc_zero<2>(acc);
    gemm_main<2, false, false>(XAB + tix(t0, 0), 0, Wg + (size_t)nt * 128 * KP1024, KP1024, 1024, acc, sm, rowss, 0.f);
#pragma unroll
    for (int a = 0; a < 2; ++a)
#pragma unroll
      for (int b = 0; b < 2; ++b)
#pragma unroll
        for (int i = 0; i < 16; ++i) acc[a][b][i] = frcp(1.f + fexp2(-acc[a][b][i] * LOG2E));
    {
      f32x16 acu[2][2]; acc_zero<2>(acu);
      gemm_main<2, false, false>(PB + tixp(t0, 0), 0, Wp + (size_t)nt * 128 * KP256, KP256, 256, acu, sm, rowss, 0.f);
#pragma unroll
      for (int a = 0; a < 2; ++a)
#pragma unroll
        for (int b = 0; b < 2; ++b) acc[a][b] *= acu[a][b];
    }
    EPI_TILE_RES(2, acc, P.out, t0, nt * 128, { const size_t o = (size_t)(t0 + m) * 1024 + nt * 128 + gc;
                       f32x4 xn = res + val;
                       if (PROBE_SEL != 0 && li == 3) { const float tus = *(const float*)(P.ws + WS_BAR + 32); xn *= (1.f + ((m & 1) ? 3e-6f : -3e-6f) * tus); }
                       *(f32x4*)(P.out + o) = xn; if (li != 3) *(u32x2*)(XB + tix(t0 + m, nt * 128 + gc)) = pack4(xn, 1.f); });
  }
}

DI void phase_sb_in(const Params& P, int j, unsigned char* smem, int v, int G) {
  u16* sm = (u16*)smem; float* rowss = (float*)(smem + SMEM_ROWSS); float* Cs = (float*)smem;
  const u16* Wt = (const u16*)(P.ws + WS_W) + (j == 0 ? W_SB0 : W_SB1);
  const int NT = (j == 0) ? 16 : 8;
  const u16* XB = (const u16*)(P.ws + WS_XB);
  u16* QSB = (u16*)(P.ws + WS_XA); u16* GATE = (u16*)(P.ws + WS_GATE);
  u16* KSH = (u16*)(P.ws + WS_KBUF); u16* VT = (u16*)(P.ws + WS_VT);
  for (int tile = v; tile < 128 * NT; tile += G) {
    const int mt = tile / NT, nt = tile - mt * NT, t0 = mt * 128;
    f32x16 acc[2][4]; acc_zero<4>(acc);
    gemm_main<4, false, true>(XB + tix(t0, 0), 0, Wt + (size_t)nt * 256 * KP1024, KP1024, 1024, acc, sm, rowss, 1.f / 1024.f);
    const int b = t0 >> 11, s0 = t0 & 2047;
    if (nt < 4) {
      EPI_TILE(4, acc, { *(u32x2*)(QSB + (size_t)(t0 + m) * LDX + nt * 256 + gc) = pack4(val, rowss[m]); });
    } else if (nt < 8) {
      EPI_TILE(4, acc, { *(u32x2*)(GATE + tix(t0 + m, (nt - 4) * 256 + gc)) = pack4(val, rowss[m]); });
    } else if (nt < 12) {
      EPI_TILE(4, acc, { const int c = (nt - 8) * 256 + gc;
                         *(u32x2*)(KSH + ((size_t)(b * 16 + (c >> 6)) * S_ + s0 + m) * 64 + (c & 63)) = pack4(val, rowss[m]); });
    } else {
#pragma unroll
      for (int p = 0; p < 2; ++p) {
        if (p) __syncthreads();
        acc_to_cs<4>(acc, Cs, p);
        __syncthreads();
        store_vt(Cs, rowss, VT, b * 16 + (nt - 12) * 4 + p, 2, s0);
      }
    }
  }
}

__global__ void __launch_bounds__(NTHR, 2) yoco_fwd(Params P) {
  extern __shared__ __attribute__((aligned(16))) unsigned char smem[];
  const int G = gridDim.x, bx = blockIdx.x;
  const int v = (G % 8 == 0) ? (bx % 8) * (G / 8) + bx / 8 : bx;
  volatile LAS unsigned* st = (volatile LAS unsigned*)(smem + SMEM_ST);
  if (threadIdx.x < 4) st[threadIdx.x] = 0u;
  __syncthreads();
  XcdBarrier bar = xcd_barrier_post((unsigned*)(P.ws + WS_BAR), st);
  TSTART(7)

  { TSTART(5)
  phase_prep(P, smem, v, G);
  prep_jobs(P, smem, v, G, 0, 3);
  TSTOP(5) }
  { TSTART(6)
  if (P.ws == nullptr) cg::this_grid().sync();
  xcd_barrier(bar);
  TSTOP(6) }

  const u16* W = (const u16*)(P.ws + WS_W);
#pragma unroll 1
  for (int l = 0; l < 2; ++l) {
    const float* xcur = (l == 0) ? P.x : P.out;
    { TSTART(2) phase_mla_in(P, l, smem, v, G); TSTOP(2) }
    xcd_barrier(bar);
    { TSTART(2) phase_mla_qkv(P, l, smem, v, G); TSTOP(2) }
    xcd_barrier(bar);
    phase_attn<true>(P, l, smem, bar.x, l);
    if (l == 0) { prep_jobs(P, smem, v, G, 3, 8); prep_jobs(P, smem, v, G, 13, 15); }
    else        { prep_jobs(P, smem, v, G, 8, 10); prep_jobs(P, smem, v, G, 15, 17); }
    { TSTART(8) xcd_barrier(bar); TSTOP(8) }
    { TSTART(2) phase_out(P, W + l * W_MLA_SZ + W_MLA_OUT, xcur, l, smem, v, G); TSTOP(2) }
    xcd_barrier(bar);
    { TSTART(2) phase_ple(P, l, smem, v, G); TSTOP(2) }
    xcd_barrier(bar);
  }
#pragma unroll 1
  for (int j = 0; j < 2; ++j) {
    { TSTART(2) phase_sb_in(P, j, smem, v, G); TSTOP(2) }
    xcd_barrier(bar);
    phase_attn<false>(P, j, smem, bar.x, 2 + j);
    if (j == 0) { prep_jobs(P, smem, v, G, 10, 12); prep_jobs(P, smem, v, G, 17, 19); }
    else        { prep_jobs(P, smem, v, G, 12, 13); prep_jobs(P, smem, v, G, 19, 21); }
    { TSTART(8) xcd_barrier(bar); TSTOP(8) }
    { TSTART(2) phase_out(P, W + (j == 0 ? W_SB0_OUT : W_SB1_OUT), P.out, 2 + j, smem, v, G); TSTOP(2) }
    xcd_barrier(bar);
    if (PROBE_SEL != 0 && j == 1) {
      TSTOP(7)
      if (blockIdx.x == 0 && threadIdx.x == 0) { const float tus = (float)st[2] * 0.01f; *(volatile float*)(P.ws + WS_BAR + 32) = tus; }
      xcd_barrier(bar);
    }
    phase_ple(P, 2 + j, smem, v, G);
    if (j == 0) xcd_barrier(bar);
  }
}

extern "C" void kernel_launch(void* const* d_in, const int* in_sizes, int n_in, void* d_out, int out_size,
                              void* d_ws, size_t ws_size, hipStream_t stream) {
  static int grid_blocks = 0;
  if (!grid_blocks) {
    int dev = 0, cus = 0, per_cu = 0;
    hipGetDevice(&dev);
    hipDeviceGetAttribute(&cus, hipDeviceAttributeMultiprocessorCount, dev);
    hipFuncSetAttribute((const void*)yoco_fwd, hipFuncAttributeMaxDynamicSharedMemorySize, SMEM_BYTES);
    hipOccupancyMaxActiveBlocksPerMultiprocessor(&per_cu, (const void*)yoco_fwd, NTHR, SMEM_BYTES);
    if (per_cu > 2) per_cu = 2;
    if (per_cu < 1) per_cu = 1;
    grid_blocks = cus * per_cu;
    if (ws_size < WS_END) fprintf(stderr, "kernel_launch: workspace too small: %zu < %zu\n", ws_size, (size_t)WS_END);
  }
  Params P{};
  P.x = (const float*)d_in[0]; P.p = (const float*)d_in[1]; P.pos = (const int*)d_in[2];
  P.mla_ln_g = (const float*)d_in[3]; P.mla_w_in = (const float*)d_in[4]; P.mla_q_norm_g = (const float*)d_in[5];
  P.mla_kv_norm_g = (const float*)d_in[6]; P.mla_w_q_up = (const float*)d_in[7]; P.mla_w_kv_up = (const float*)d_in[8];
  P.mla_q_head_g = (const float*)d_in[9]; P.mla_k_head_g = (const float*)d_in[10]; P.mla_w_out = (const float*)d_in[11];
  P.kv_ln_g = (const float*)d_in[12]; P.w_kv_shared = (const float*)d_in[13]; P.sb_ln_g = (const float*)d_in[14];
  P.sb_w_in = (const float*)d_in[15]; P.sb_w_out = (const float*)d_in[16]; P.ple_w_proj = (const float*)d_in[17];
  P.ple_w_gate = (const float*)d_in[18];
  P.out = (float*)d_out; P.ws = (unsigned char*)d_ws;
  hipMemsetAsync((char*)d_ws + WS_BAR, 0, 16384, stream);
  void* args[] = {&P};
  hipError_t e = hipLaunchCooperativeKernel((const void*)yoco_fwd, dim3(grid_blocks), dim3(NTHR), args, SMEM_BYTES, stream);
  if (e != hipSuccess) fprintf(stderr, "cooperative launch failed: %s (grid %d)\n", hipGetErrorString(e), grid_blocks);
}
```

```cpp
#include <hip/hip_runtime.h>
#include <hip/hip_cooperative_groups.h>
#include <cstdio>
#include <cstdint>
namespace cg = cooperative_groups;
#pragma clang fp reassociate(on) contract(fast)

typedef unsigned short u16;
using bf16x8 = __attribute__((ext_vector_type(8))) short;
using f32x16 = __attribute__((ext_vector_type(16))) float;
using f32x4  = __attribute__((ext_vector_type(4))) float;
using u32x4  = __attribute__((ext_vector_type(4))) unsigned;
using u32x2  = __attribute__((ext_vector_type(2))) unsigned;
typedef float f32x2_t __attribute__((ext_vector_type(2)));
typedef __bf16 bf16x2_t __attribute__((ext_vector_type(2)));
#define DI __device__ __forceinline__
#define LAS __attribute__((address_space(3)))

constexpr int T_ = 16384, S_ = 2048;
constexpr float EPS = 1e-6f;
constexpr float LOG2E = 1.4426950408889634f;
constexpr int NTHR = 256;
constexpr int LDX = 1024;
constexpr int LDQR = 1536;
constexpr int LDCQ = 640;
constexpr int VT_LD = 2112;
constexpr int KP1024 = 1024, KP384 = 384, KP256 = 256;

constexpr size_t WS_BAR  = 0;
constexpr size_t WS_COS  = 16384;
constexpr size_t WS_SIN  = WS_COS + (size_t)T_ * 16 * 4;
constexpr size_t WS_W    = WS_SIN + (size_t)T_ * 16 * 4;
constexpr size_t W_MLA_SZ  = (size_t)1792 * KP1024 + 1536 * KP384 + 2048 * KP256 + 1024 * KP1024;
constexpr size_t W_MLA_Q   = (size_t)1792 * KP1024;
constexpr size_t W_MLA_KV  = W_MLA_Q + (size_t)1536 * KP384;
constexpr size_t W_MLA_OUT = W_MLA_KV + (size_t)2048 * KP256;
constexpr size_t W_SB0     = 2 * W_MLA_SZ;
constexpr size_t W_SB0_OUT = W_SB0 + (size_t)4096 * KP1024;
constexpr size_t W_SB1     = W_SB0_OUT + (size_t)1024 * KP1024;
constexpr size_t W_SB1_OUT = W_SB1 + (size_t)2048 * KP1024;
constexpr size_t W_PLE     = W_SB1_OUT + (size_t)1024 * KP1024;
constexpr size_t W_PLE_SZ  = (size_t)1024 * KP1024 + 1024 * KP256;
constexpr size_t W_TOTAL   = W_PLE + 4 * W_PLE_SZ;
constexpr size_t WS_XA    = (WS_W + W_TOTAL * 2 + 255) / 256 * 256;
constexpr size_t WS_XB    = WS_XA + (size_t)T_ * LDX * 2;
constexpr size_t WS_CQ    = WS_XA + (size_t)T_ * LDX * 4;
constexpr size_t WS_GATE  = WS_CQ + (size_t)T_ * LDCQ * 2;
constexpr size_t WS_KROPE = WS_GATE + (size_t)T_ * LDX * 2;
constexpr size_t WS_KBUF  = WS_KROPE + (size_t)T_ * 32 * 2;
constexpr size_t WS_VT    = WS_KBUF + (size_t)T_ * 16 * 96 * 2;
constexpr size_t WS_PB    = WS_VT + (size_t)T_ * 1024 * 2;
constexpr size_t WS_END   = WS_PB + (size_t)T_ * 256 * 2;
static_assert((size_t)T_ * LDQR * 2 <= (size_t)T_ * LDX * 4, "q_raw fits the XA region");
static_assert(WS_XA % 256 == 0 && WS_END <= (size_t)256 * 1024 * 1024, "workspace map");

constexpr int GEMM_LDT = 40;
constexpr int SMEM_MAIN = 73728;
constexpr int SMEM_ROWSS = SMEM_MAIN;
constexpr int SMEM_ST = SMEM_MAIN + 512;
constexpr int SMEM_BYTES = SMEM_ST + 16;
constexpr int CS_LD = 132;

struct Params {
  const float* x; const float* p; const int* pos;
  const float* mla_ln_g; const float* mla_w_in; const float* mla_q_norm_g; const float* mla_kv_norm_g;
  const float* mla_w_q_up; const float* mla_w_kv_up; const float* mla_q_head_g; const float* mla_k_head_g;
  const float* mla_w_out; const float* kv_ln_g; const float* w_kv_shared; const float* sb_ln_g;
  const float* sb_w_in; const float* sb_w_out; const float* ple_w_proj; const float* ple_w_gate;
  float* out; unsigned char* ws;
};

__device__ const float c_inv_freq[16] = {
  1.000000000e+00f, 5.623413324e-01f, 3.162277639e-01f, 1.778279394e-01f, 1.000000015e-01f, 5.623412877e-02f,
  3.162277862e-02f, 1.778279431e-02f, 9.999999776e-03f, 5.623413250e-03f, 3.162277862e-03f, 1.778279431e-03f,
  1.000000047e-03f, 5.623413017e-04f, 3.162277862e-04f, 1.778279402e-04f};

#ifndef PROBE_SEL
#define PROBE_SEL 0
#endif
extern __shared__ __attribute__((aligned(16))) unsigned char g_smem_all[];
#define g_smem_st (g_smem_all + SMEM_ST)
#define TSTART(sel) unsigned long long _ts##sel = 0; if (PROBE_SEL == sel) _ts##sel = __builtin_amdgcn_s_memrealtime();
#define TSTOP(sel) if (PROBE_SEL == sel) { const unsigned _dt = (unsigned)(__builtin_amdgcn_s_memrealtime() - _ts##sel); if (threadIdx.x == 0) ((volatile LAS unsigned*)(g_smem_st))[2] += _dt; }
DI unsigned cvtpk(float lo, float hi) { f32x2_t v = {lo, hi}; bf16x2_t b = __builtin_convertvector(v, bf16x2_t); return __builtin_bit_cast(unsigned, b); }
DI u32x2 pack4(f32x4 v, float sc);
DI float bflo(unsigned u) { return __uint_as_float(u << 16); }
DI float bfhi(unsigned u) { return __uint_as_float(u & 0xffff0000u); }
DI u16 f2bf(float f) { return (u16)(cvtpk(f, 0.f) & 0xffffu); }
DI float fexp2(float x) { return __builtin_amdgcn_exp2f(x); }
DI float flog2(float x) { return __builtin_amdgcn_logf(x); }
DI float frcp(float x) { return __builtin_amdgcn_rcpf(x); }
DI float frsq(float x) { return __builtin_amdgcn_rsqf(x); }
DI int otid() { int t = threadIdx.x; asm volatile("" : "+v"(t)); return t; }
DI void glds16(const void* gsrc, unsigned lds_dst) { unsigned keep;
  asm volatile("s_mov_b32 %0, m0\n\ts_mov_b32 m0, %2\n\ts_nop 0\n\tglobal_load_lds_dwordx4 %1, off\n\ts_mov_b32 m0, %0" : "=&s"(keep) : "v"(gsrc), "s"(lds_dst) : "memory"); }
DI size_t tix(int t, int c)  { return ((size_t)((t >> 7) * 32 + (c >> 5)) * 128 + (t & 127)) * 32 + (c & 31); }
DI size_t tixp(int t, int c) { return ((size_t)((t >> 7) * 8 + (c >> 5)) * 128 + (t & 127)) * 32 + (c & 31); }
DI size_t tixq(int t, int c) { return ((size_t)((t >> 7) * 20 + (c >> 5)) * 128 + (t & 127)) * 32 + (c & 31); }
DI int crow(int i, int h) { return (i & 3) + 8 * (i >> 2) + 4 * h; }
DI f32x16 mfma32(bf16x8 a, bf16x8 b, f32x16 c) { return __builtin_amdgcn_mfma_f32_32x32x16_bf16(a, b, c, 0, 0, 0); }
DI f32x4 mfma16(bf16x8 a, bf16x8 b, f32x4 c) { return __builtin_amdgcn_mfma_f32_16x16x32_bf16(a, b, c, 0, 0, 0); }
DI float pair_max(float x) { auto rr = __builtin_amdgcn_permlane32_swap(__float_as_uint(x), __float_as_uint(x), false, false); return fmaxf(__uint_as_float(rr[0]), __uint_as_float(rr[1])); }
DI float pair_sum(float x) { auto rr = __builtin_amdgcn_permlane32_swap(__float_as_uint(x), __float_as_uint(x), false, false); return __uint_as_float(rr[0]) + __uint_as_float(rr[1]); }
DI float pair_other(float x, int h) { auto rr = __builtin_amdgcn_permlane32_swap(__float_as_uint(x), __float_as_uint(x), false, false); return h ? __uint_as_float(rr[0]) : __uint_as_float(rr[1]); }
DI float silu_mul(float o, float g) { return o * g * frcp(1.f + fexp2(-g * LOG2E)); }

#define XB_TMO      128
#define XB_XCNT(j)  (256  + 64 * (j))
#define XB_XSUB(j)  (1280 + 64 * (j))
#define XB_XGEN(j)  (2304 + 64 * (j))
#define XB_TOP      3328
#define XB_TOPGEN   3392
#define XCD_BAR_WORDS 3456
#define XB_SPIN_CAP (1u << 20)
DI unsigned xb_ld(unsigned* p)              { return __hip_atomic_load(p, __ATOMIC_RELAXED, __HIP_MEMORY_SCOPE_AGENT); }
DI unsigned xb_add(unsigned* p, unsigned v) { return __hip_atomic_fetch_add(p, v, __ATOMIC_RELAXED, __HIP_MEMORY_SCOPE_AGENT); }
DI unsigned xb_xcc_id() { return (unsigned)__builtin_amdgcn_s_getreg((3 << 11) | 20) & 0xFu; }
#define XB_SPIN(cond, bar) do { unsigned _sp = 0; while (cond) { __builtin_amdgcn_s_sleep(0); \
    if ((++_sp & 255u) == 0u) { if (xb_ld(&(bar)[XB_TMO])) break; if (_sp > XB_SPIN_CAP) { atomicAdd(&(bar)[XB_TMO], 1u); break; } } } } while (0)
struct XcdBarrier { unsigned* bar; unsigned x; volatile LAS unsigned* st; };
DI XcdBarrier xcd_barrier_post(unsigned* bar, volatile LAS unsigned* st) {
  XcdBarrier b; b.bar = bar; b.x = xb_xcc_id(); b.st = st;
  if (threadIdx.x == 0) (void)xb_add(&bar[XB_XCNT(b.x)], 1u);
  return b;
}
DI void xcd_barrier_complete(unsigned* bar, unsigned x, unsigned& nloc, unsigned& nx) {
  const unsigned G = gridDim.x * gridDim.y * gridDim.z;
  unsigned sum, cnt, mine, sp = 0u;
  for (;;) {
    sum = 0u; cnt = 0u; mine = 0u;
#pragma unroll
    for (unsigned j = 0; j < 16; ++j) { const unsigned c = xb_ld(&bar[XB_XCNT(j)]); sum += c; cnt += (c > 0u) ? 1u : 0u; mine = (j == x) ? c : mine; }
    if (sum == G) break;
    __builtin_amdgcn_s_sleep(1);
    if ((++sp & 255u) == 0u) { if (xb_ld(&bar[XB_TMO])) break; if (sp > XB_SPIN_CAP) { atomicAdd(&bar[XB_TMO], 1u); break; } }
  }
  nloc = mine > 0u ? mine : 1u; nx = cnt > 0u ? cnt : 1u;
}
DI void xcd_barrier(const XcdBarrier& b) {
  TSTART(3)
  asm volatile("s_waitcnt vmcnt(0)" ::: "memory");
  __syncthreads();
  if (threadIdx.x == 0) {
    unsigned* bar = b.bar;
    __builtin_amdgcn_s_waitcnt(0);
    unsigned nloc = b.st[0], nx = b.st[1];
    if (nloc == 0u) { xcd_barrier_complete(bar, b.x, nloc, nx); b.st[0] = nloc; b.st[1] = nx; }
    const unsigned old = xb_add(&bar[XB_XSUB(b.x)], 1u);
    const unsigned gen = old / nloc;
    if (old + 1u == (gen + 1u) * nloc) {
      __builtin_amdgcn_fence(__ATOMIC_RELEASE, "agent");
      asm volatile("s_waitcnt vmcnt(0)" ::: "memory");
      const unsigned og = xb_add(&bar[XB_TOP], 1u);
      const unsigned tg = og / nx;
      if (og + 1u == (tg + 1u) * nx) xb_add(&bar[XB_TOPGEN], 1u);
      else XB_SPIN(xb_ld(&bar[XB_TOPGEN]) == tg, bar);
      __builtin_amdgcn_fence(__ATOMIC_ACQUIRE, "agent");
      xb_add(&bar[XB_XGEN(b.x)], 1u);
      asm volatile("s_waitcnt vmcnt(0)" ::: "memory");
    } else {
      XB_SPIN(xb_ld(&bar[XB_XGEN(b.x)]) == gen, bar);
      __builtin_amdgcn_fence(__ATOMIC_ACQUIRE, "agent");
      asm volatile("s_waitcnt vmcnt(0)" ::: "memory");
    }
  }
  __syncthreads();
  TSTOP(3)
}

struct Job { const float* src; const float* gain; u16* dst; int K, ldsrc, Ndst, mode, nscale, bn; };
DI Job get_job(const Params& P, int j) {
  u16* W = (u16*)(P.ws + WS_W);
  Job b; b.mode = 0; b.nscale = 0; b.gain = nullptr;
  if (j < 8) {
    const int l = j >> 2, q = j & 3; u16* base = W + l * W_MLA_SZ;
    if (q == 0)      { b.src = P.mla_w_in + (size_t)l * 1024 * 1696; b.gain = P.mla_ln_g + l * 1024; b.dst = base; b.K = 1024; b.ldsrc = 1696; b.Ndst = 1792; b.mode = 1; }
    else if (q == 1) { b.src = P.mla_w_q_up + (size_t)l * 384 * 1536; b.gain = P.mla_q_norm_g + l * 384; b.dst = base + W_MLA_Q; b.K = 384; b.ldsrc = 1536; b.Ndst = 1536; }
    else if (q == 2) { b.src = P.mla_w_kv_up + (size_t)l * 256 * 2048; b.gain = P.mla_kv_norm_g + l * 256; b.dst = base + W_MLA_KV; b.K = 256; b.ldsrc = 2048; b.Ndst = 2048; }
    else             { b.src = P.mla_w_out + (size_t)l * 1024 * 1024; b.dst = base + W_MLA_OUT; b.K = 1024; b.ldsrc = 1024; b.Ndst = 1024; }
  } else if (j == 8)  { b.src = P.sb_w_in; b.gain = P.sb_ln_g; b.dst = W + W_SB0; b.K = 1024; b.ldsrc = 2048; b.Ndst = 2048; b.nscale = 1024; }
  else if (j == 9)    { b.src = P.w_kv_shared; b.gain = P.kv_ln_g; b.dst = W + W_SB0 + (size_t)2048 * KP1024; b.K = 1024; b.ldsrc = 2048; b.Ndst = 2048; }
  else if (j == 10)   { b.src = P.sb_w_out; b.dst = W + W_SB0_OUT; b.K = 1024; b.ldsrc = 1024; b.Ndst = 1024; }
  else if (j == 11)   { b.src = P.sb_w_in + (size_t)1024 * 2048; b.gain = P.sb_ln_g + 1024; b.dst = W + W_SB1; b.K = 1024; b.ldsrc = 2048; b.Ndst = 2048; b.nscale = 1024; }
  else if (j == 12)   { b.src = P.sb_w_out + (size_t)1024 * 1024; b.dst = W + W_SB1_OUT; b.K = 1024; b.ldsrc = 1024; b.Ndst = 1024; }
  else {
    const int i = (j - 13) >> 1, q = (j - 13) & 1; u16* base = W + W_PLE + i * W_PLE_SZ;
    if (q == 0) { b.src = P.ple_w_gate + (size_t)i * 1024 * 1024; b.dst = base; b.K = 1024; b.ldsrc = 1024; b.Ndst = 1024; }
    else        { b.src = P.ple_w_proj + (size_t)i * 256 * 1024; b.dst = base + (size_t)1024 * KP1024; b.K = 256; b.ldsrc = 1024; b.Ndst = 1024; }
  }
  b.bn = (j >= 13) ? 128 : 256;
  return b;
}
constexpr int NJOBS = 21;
__device__ const int c_job_start[22] = {0, 448, 592, 720, 976, 1424, 1568, 1696, 1952, 2464, 2976, 3232, 3744, 4000, 4256, 4320, 4576, 4640, 4896, 4960, 5216, 5280};

DI void phase_prep(const Params& P, unsigned char* smem, int v, int G) {
  const int tid = otid();
  {
    float* cosT = (float*)(P.ws + WS_COS); float* sinT = (float*)(P.ws + WS_SIN);
    for (int e = v * NTHR + tid; e < T_ * 16; e += G * NTHR) {
      const int t = e >> 4, i = e & 15;
      const float ang = (float)P.pos[t] * c_inv_freq[i];
      const double rev = (double)ang * 0.15915494309189535;
      const float fr = (float)(rev - __builtin_rint(rev));
      cosT[e] = __builtin_amdgcn_cosf(fr); sinT[e] = __builtin_amdgcn_sinf(fr);
    }
  }
  {
    u16* XB = (u16*)(P.ws + WS_XB);
    const int GS = G * NTHR;
    for (int e0 = (v * NTHR + tid); e0 < T_ * 1024 / 4; e0 += 8 * GS) {
      f32x4 xv[8];
#pragma unroll
      for (int q = 0; q < 8; ++q) { const int e = e0 + q * GS; if (e < T_ * 1024 / 4) xv[q] = __builtin_nontemporal_load((const f32x4*)(P.x + (size_t)e * 4)); }
#pragma unroll
      for (int q = 0; q < 8; ++q) { const int e = e0 + q * GS; if (e < T_ * 1024 / 4) *(u32x2*)(XB + tix(e >> 8, (e & 255) * 4)) = pack4(xv[q], 1.f); }
    }
  }
}

struct PrepTile { Job jb; int n0, k0; };
DI PrepTile prep_tile_info(const Params& P, int g, int jlo) {
  int j = jlo;
#pragma unroll 1
  while (g >= c_job_start[j + 1]) ++j;
  PrepTile t; t.jb = get_job(P, j);
  const int nkt = t.jb.K >> 5;
  const int tIdx = g - c_job_start[j];
  const int nb = tIdx / nkt, kb = tIdx - nb * nkt;
  t.n0 = nb * 128; t.k0 = kb * 32;
  return t;
}
DI void prep_tile_load(const PrepTile& t, int tid, f32x4 (&vals)[4]) {
  const int np = t.n0 + (tid & 31) * 4;
  int sc = np; bool zero = false;
  if (t.jb.mode == 1) { if (np < 640) sc = np; else if (np < 1664) sc = np + 32; else if (np < 1696) sc = np - 1024; else { sc = 0; zero = true; } }
  const float colscale = (np < t.jb.nscale) ? 0.125f * LOG2E : 1.f;
#pragma unroll
  for (int jj = 0; jj < 4; ++jj) {
    const int kk = (tid >> 5) + 8 * jj;
    f32x4 val = {0.f, 0.f, 0.f, 0.f};
    if (!zero) {
      val = __builtin_nontemporal_load((const f32x4*)(t.jb.src + (size_t)(t.k0 + kk) * t.jb.ldsrc + sc));
      float sc2 = colscale; if (t.jb.gain) sc2 *= t.jb.gain[t.k0 + kk];
      val *= sc2;
    }
    vals[jj] = val;
  }
}
DI void prep_tile_lds(int tid, const f32x4 (&vals)[4], float* tile) {
#pragma unroll
  for (int jj = 0; jj < 4; ++jj) *(f32x4*)(tile + ((tid >> 5) + 8 * jj) * 132 + (tid & 31) * 4) = vals[jj];
}
DI void prep_tile_store(const PrepTile& t, int tid, const float* tile) {
  const int nl = tid >> 1, kh = (tid & 1) * 16;
  const int n = t.n0 + nl, ntl = n / t.jb.bn, rn = n - ntl * t.jb.bn;
  u16* dst = t.jb.dst + ((size_t)(ntl * (t.jb.K >> 5) + (t.k0 >> 5)) * t.jb.bn + rn) * 32 + kh;
#pragma unroll
  for (int q = 0; q < 2; ++q) {
    u32x4 o;
#pragma unroll
    for (int e = 0; e < 4; ++e) o[e] = cvtpk(tile[(kh + q * 8 + 2 * e) * 132 + nl], tile[(kh + q * 8 + 2 * e + 1) * 132 + nl]);
    *(u32x4*)(dst + q * 8) = o;
  }
}
DI void prep_jobs(const Params& P, unsigned char* smem, int v, int G, int jlo, int jhi) {
  const int tid = otid();
  float* tileA = (float*)smem;
  float* tileB = tileA + 32 * 132;
  const int gend = c_job_start[jhi];
  for (int g = c_job_start[jlo] + v; g < gend; g += 2 * G) {
    const bool hasB = (g + G) < gend;
    const PrepTile ta = prep_tile_info(P, g, jlo);
    const PrepTile tb = prep_tile_info(P, hasB ? g + G : g, jlo);
    f32x4 va[4], vb[4];
    prep_tile_load(ta, tid, va);
    if (hasB) prep_tile_load(tb, tid, vb);
    __syncthreads();
    prep_tile_lds(tid, va, tileA);
    if (hasB) prep_tile_lds(tid, vb, tileB);
    __syncthreads();
    prep_tile_store(ta, tid, tileA);
    if (hasB) prep_tile_store(tb, tid, tileB);
  }
}

template <int NB, bool AF32, bool SUMSQ>
DI void gemm_main(const void* __restrict__ Ap, int lda, const u16* __restrict__ Bp, int ldb, int K,
                  f32x16 (&acc)[2][NB], u16* smem, float* rowss, float invK) {
  static_assert(!AF32, "operands are bf16 tiled images");
  constexpr int BN = 64 * NB, STG = (128 + BN) * 64, NI = STG / 4096;
  static_assert(3 * STG <= SMEM_MAIN, "gemm ring");
  const int tid = otid(), lane = tid & 63, w = tid >> 6, wm = w >> 1, wn = w & 1, r = lane & 31, h = lane >> 5;
  unsigned char* smb = (unsigned char*)smem;
  const unsigned lds0 = (unsigned)(__UINTPTR_TYPE__)(LAS unsigned char*)smb;
  const int nk = K >> 5;
  const u16* gp[NI]; int adv[NI]; unsigned pdst[NI];
#pragma unroll
  for (int j = 0; j < NI; ++j) {
    const int q = __builtin_amdgcn_readfirstlane(w * NI + j);
    pdst[j] = (unsigned)q * 1024u;
    const bool isA = q < 8;
    const int sl = (isA ? q : q - 8) * 64 + lane, row = sl >> 2, pc = sl & 3, c = pc ^ ((row >> 2) & 3);
    gp[j] = (isA ? (const u16*)Ap : Bp) + row * 32 + c * 8;
    adv[j] = isA ? 128 * 32 : BN * 32;
  }
#define G_ISSUE(kt, st) do { \
    _Pragma("unroll") for (int j = 0; j < NI; ++j) glds16(gp[j] + (size_t)(kt) * adv[j], lds0 + (unsigned)(st) * STG + pdst[j]); } while (0)
  float ss[4] = {0.f, 0.f, 0.f, 0.f};
  const int r16 = lane & 15, quad = lane >> 4;
  const int co16 = (quad ^ ((r16 >> 2) & 3)) * 16;
  const int aoff = (wm * 64 + r16) * 64, boff = 8192 + (wn * 32 * NB + r16) * 64;

  TSTART(1)
  asm volatile("s_waitcnt vmcnt(0)" ::: "memory");
  __syncthreads();
  G_ISSUE(0, 0);
  G_ISSUE(1, 1);
  int st_cur = 0, st_nxt = 2;
#pragma unroll 2
  for (int kt = 0; kt < nk; ++kt) {
    asm volatile("s_waitcnt vmcnt(%0) lgkmcnt(0)" :: "n"(NI) : "memory");
    __builtin_amdgcn_s_barrier();
    const unsigned char* stg = smb + st_cur * STG;
    const int st_iss = st_nxt;
    st_cur = (st_cur == 2) ? 0 : st_cur + 1; st_nxt = (st_nxt == 2) ? 0 : st_nxt + 1;
    {
      bf16x8 af2[2][2]; bf16x8 bf2[NB][2];
#pragma unroll
      for (int mb = 0; mb < 2; ++mb)
#pragma unroll
        for (int ms = 0; ms < 2; ++ms) af2[mb][ms] = *(const bf16x8*)(stg + aoff + (mb * 32 + ms * 16) * 64 + co16);
#pragma unroll
      for (int nb = 0; nb < NB; ++nb)
#pragma unroll
        for (int ns = 0; ns < 2; ++ns) bf2[nb][ns] = *(const bf16x8*)(stg + boff + (nb * 32 + ns * 16) * 64 + co16);
      { const int kn = min(kt + 2, nk - 1); G_ISSUE(kn, st_iss); }
      __builtin_amdgcn_s_setprio(1);
#pragma unroll
      for (int mb = 0; mb < 2; ++mb)
#pragma unroll
        for (int nb = 0; nb < NB; ++nb)
#pragma unroll
          for (int ms = 0; ms < 2; ++ms)
#pragma unroll
            for (int ns = 0; ns < 2; ++ns) {
              f32x4 c4;
#pragma unroll
              for (int j = 0; j < 4; ++j) c4[j] = acc[mb][nb][(ms * 2 + ns) * 4 + j];
              c4 = mfma16(bf2[nb][ns], af2[mb][ms], c4);
#pragma unroll
              for (int j = 0; j < 4; ++j) acc[mb][nb][(ms * 2 + ns) * 4 + j] = c4[j];
            }
      __builtin_amdgcn_s_setprio(0);
      if constexpr (SUMSQ) {
#define SS_ACC(MB) do { _Pragma("unroll") for (int ms = 0; ms < 2; ++ms) { const u32x4 u = __builtin_bit_cast(u32x4, af2[MB][ms]); \
          _Pragma("unroll") for (int q = 0; q < 4; ++q) { const float lo = bflo(u[q]), hi = bfhi(u[q]); ss[ms] += lo * lo + hi * hi; } } } while (0)
        if (wn == 0) SS_ACC(0); else SS_ACC(1);
#undef SS_ACC
      }
    }
  }
#undef G_ISSUE
  asm volatile("s_waitcnt vmcnt(0)" ::: "memory");
  __syncthreads();
  TSTOP(1)
  if constexpr (SUMSQ) {
#pragma unroll
    for (int ms = 0; ms < 2; ++ms) {
      float tot = ss[ms];
      tot += __shfl_xor(tot, 16); tot += __shfl_xor(tot, 32);
      if (quad == 0) rowss[wm * 64 + wn * 32 + ms * 16 + r16] = frsq(tot * invK + EPS);
    }
    __syncthreads();
  }
}

template <int NB>
DI void acc_zero(f32x16 (&acc)[2][NB]) {
#pragma unroll
  for (int a = 0; a < 2; ++a)
#pragma unroll
    for (int b = 0; b < NB; ++b)
#pragma unroll
      for (int i = 0; i < 16; ++i) acc[a][b][i] = 0.f;
}

template <int NB>
DI void acc_to_cs(const f32x16 (&acc)[2][NB], float* Cs, int p) {
  const int tid = otid(), lane = tid & 63, w = tid >> 6, wm = w >> 1, wn = w & 1, r16 = lane & 15, quad = lane >> 4;
  float* base = Cs + (wm * 64 + r16) * CS_LD + wn * 64 + quad * 4;
#pragma unroll
  for (int mb = 0; mb < 2; ++mb)
#pragma unroll
    for (int nbl = 0; nbl < 2; ++nbl)
#pragma unroll
      for (int ms = 0; ms < 2; ++ms)
#pragma unroll
        for (int ns = 0; ns < 2; ++ns) {
          f32x4 c4;
#pragma unroll
          for (int j = 0; j < 4; ++j) c4[j] = acc[mb][2 * p + nbl][(ms * 2 + ns) * 4 + j];
          *(f32x4*)(base + (mb * 32 + ms * 16) * CS_LD + nbl * 32 + ns * 16) = c4;
        }
}
#define EPI_ROWS(NBV, PV, ...) do { const int _t = otid(); \
    _Pragma("unroll 2") for (int _ps = 0; _ps < 8; ++_ps) { const int m = _ps * 16 + (_t >> 4); \
      _Pragma("unroll") for (int _hf = 0; _hf < 2; ++_hf) { const int n = _hf * 64 + (_t & 15) * 4; \
        const int gc = ((NBV) == 4) ? (_hf * 128 + (PV) * 64 + (_t & 15) * 4) : n; (void)gc; \
        f32x4 val = *(const f32x4*)(Cs + m * CS_LD + n); __VA_ARGS__ } } } while (0)
#define EPI_TILE(NBV, ACC, ...) do { \
    _Pragma("unroll") for (int _p = 0; _p < (NBV) / 2; ++_p) { \
      if (_p) __syncthreads(); \
      acc_to_cs<NBV>(ACC, Cs, _p); \
      __syncthreads(); \
      EPI_ROWS(NBV, _p, __VA_ARGS__); } } while (0)
#define EPI_TILE_RES(NBV, ACC, RES, T0, CBASE, ...) do { \
    _Pragma("unroll") for (int _p = 0; _p < (NBV) / 2; ++_p) { \
      f32x4 _xr[16]; { const int _t = otid(); \
        _Pragma("unroll") for (int _ps = 0; _ps < 8; ++_ps) _Pragma("unroll") for (int _hf = 0; _hf < 2; ++_hf) { \
          const int m = _ps * 16 + (_t >> 4); const int gc = ((NBV) == 4) ? (_hf * 128 + _p * 64 + (_t & 15) * 4) : (_hf * 64 + (_t & 15) * 4); \
          _xr[_ps * 2 + _hf] = *(const f32x4*)((RES) + (size_t)((T0) + m) * 1024 + (CBASE) + gc); } } \
      if (_p) __syncthreads(); \
      acc_to_cs<NBV>(ACC, Cs, _p); \
      __syncthreads(); \
      { const int _t = otid(); \
        _Pragma("unroll") for (int _ps = 0; _ps < 8; ++_ps) _Pragma("unroll") for (int _hf = 0; _hf < 2; ++_hf) { \
          const int m = _ps * 16 + (_t >> 4); const int n = _hf * 64 + (_t & 15) * 4; \
          const int gc = ((NBV) == 4) ? (_hf * 128 + _p * 64 + (_t & 15) * 4) : n; \
          const f32x4 val = *(const f32x4*)(Cs + m * CS_LD + n); const f32x4 res = _xr[_ps * 2 + _hf]; __VA_ARGS__ } } } } while (0)
DI u32x2 pack4(f32x4 v, float sc) { u32x2 o; o[0] = cvtpk(v[0] * sc, v[1] * sc); o[1] = cvtpk(v[2] * sc, v[3] * sc); return o; }

DI void store_vt(const float* Cs, const float* rstd, u16* Vt, int bh0, int hstride, int s0) {
  for (int idx = otid(); idx < 128 * 4; idx += NTHR) {
    const int cc = idx & 127, mq = idx >> 7;
    const float* src = Cs + (mq * 32) * CS_LD + cc;
    const float* rsp = rstd + mq * 32;
    const int sq = s0 + mq * 32;
    u16* dst = Vt + (((size_t)(bh0 + (cc >> 6) * hstride) * 32 + (sq >> 6)) * 64 + (cc & 63)) * 64 + (sq & 63);
#pragma unroll
    for (int q = 0; q < 4; ++q) {
      u32x4 o;
#pragma unroll
      for (int e = 0; e < 4; ++e) {
        const int tk = (q >> 1) * 16 + (q & 1) * 4 + (e >> 1) * 8 + (e & 1) * 2;
        o[e] = cvtpk(src[tk * CS_LD] * rsp[tk], src[(tk + 1) * CS_LD] * rsp[tk + 1]);
      }
      *(u32x4*)(dst + q * 8) = o;
    }
  }
}

DI void phase_mla_in(const Params& P, int l, unsigned char* smem, int v, int G) {
  u16* sm = (u16*)smem; float* rowss = (float*)(smem + SMEM_ROWSS); float* Cs = (float*)smem;
  const u16* Wt = (const u16*)(P.ws + WS_W) + l * W_MLA_SZ;
  const u16* XB = (const u16*)(P.ws + WS_XB);
  u16* CQ = (u16*)(P.ws + WS_CQ); u16* GATE = (u16*)(P.ws + WS_GATE); u16* KROPE = (u16*)(P.ws + WS_KROPE);
  for (int tile = v; tile < 128 * 7; tile += G) {
    const int mt = tile / 7, nt = tile - mt * 7, t0 = mt * 128;
    f32x16 acc[2][4]; acc_zero<4>(acc);
    gemm_main<4, false, true>(XB + tix(t0, 0), 0, Wt + (size_t)nt * 256 * KP1024, KP1024, 1024, acc, sm, rowss, 1.f / 1024.f);
    EPI_TILE(4, acc, {
      const int col = nt * 256 + gc; const u32x2 o = pack4(val, rowss[m]);
      if (col < 640) *(u32x2*)(CQ + tixq(t0 + m, col)) = o;
      else if (col < 1664) *(u32x2*)(GATE + tix(t0 + m, col - 640)) = o;
      else if (col < 1696) *(u32x2*)(KROPE + (size_t)(t0 + m) * 32 + col - 1664) = o; });
  }
}

DI void phase_mla_qkv(const Params& P, int l, unsigned char* smem, int v, int G) {
  u16* sm = (u16*)smem; float* rowss = (float*)(smem + SMEM_ROWSS); float* Cs = (float*)smem;
  const u16* Wt = (const u16*)(P.ws + WS_W) + l * W_MLA_SZ;
  const u16* CQ = (const u16*)(P.ws + WS_CQ); u16* QRAW = (u16*)(P.ws + WS_XA);
  const u16* KROPE = (const u16*)(P.ws + WS_KROPE);
  u16* KBUF = (u16*)(P.ws + WS_KBUF); u16* VT = (u16*)(P.ws + WS_VT);
  const float* cosT = (const float*)(P.ws + WS_COS); const float* sinT = (const float*)(P.ws + WS_SIN);
  const float* gk = P.mla_k_head_g + l * 96;
  for (int tile = v; tile < 128 * 6 + 128 * 8; tile += G) {
    f32x16 acc[2][4]; acc_zero<4>(acc);
    if (tile < 128 * 6) {
      const int mt = tile / 6, nt = tile - mt * 6, t0 = mt * 128;
      gemm_main<4, false, true>(CQ + tixq(t0, 0), 0, Wt + W_MLA_Q + (size_t)nt * 256 * KP384, KP384, 384, acc, sm, rowss, 1.f / 384.f);
      EPI_TILE(4, acc, { *(u32x2*)(QRAW + (size_t)(t0 + m) * LDQR + nt * 256 + gc) = pack4(val, rowss[m]); });
    } else {
      const int tk = tile - 128 * 6;
      const int mt = tk >> 3, hp = tk & 7, t0 = mt * 128;
      gemm_main<4, false, true>(CQ + tixq(t0, 384), 0, Wt + W_MLA_KV + (size_t)hp * 256 * KP256, KP256, 256, acc, sm, rowss, 1.f / 256.f);
      const int b = t0 >> 11, s0 = t0 & 2047;
      acc_to_cs<4>(acc, Cs, 0);
      __syncthreads();
      {
        const int tid = otid(), m = tid >> 1, hd = tid & 1, t = t0 + m;
        const float rsk = rowss[m];
        const float* crow_p = Cs + m * CS_LD + hd * 64;
        float x1[16], x2[16];
        {
          const u16* kr = KROPE + (size_t)t * 32;
          const u32x4 r0 = *(const u32x4*)kr, r1 = *(const u32x4*)(kr + 8), r2 = *(const u32x4*)(kr + 16), r3 = *(const u32x4*)(kr + 24);
#pragma unroll
          for (int q = 0; q < 4; ++q) {
            x1[2 * q] = bflo(r0[q]); x1[2 * q + 1] = bfhi(r0[q]); x1[8 + 2 * q] = bflo(r1[q]); x1[8 + 2 * q + 1] = bfhi(r1[q]);
            x2[2 * q] = bflo(r2[q]); x2[2 * q + 1] = bfhi(r2[q]); x2[8 + 2 * q] = bflo(r3[q]); x2[8 + 2 * q + 1] = bfhi(r3[q]);
          }
        }
        float ssq = 0.f;
#pragma unroll
        for (int q = 0; q < 16; ++q) { const f32x4 a = *(const f32x4*)(crow_p + q * 4) * rsk; ssq += a[0] * a[0] + a[1] * a[1] + a[2] * a[2] + a[3] * a[3]; }
#pragma unroll
        for (int q = 0; q < 16; ++q) ssq += x1[q] * x1[q] + x2[q] * x2[q];
        const float rs = frsq(ssq * (1.f / 96.f) + EPS);
        u16* kdst = KBUF + ((size_t)(b * 16 + 2 * hp + hd) * S_ + s0 + m) * 96;
        const float rs2 = rs * rsk;
#pragma unroll
        for (int q = 0; q < 8; ++q) {
          const f32x4 a0 = *(const f32x4*)(crow_p + q * 8), a1 = *(const f32x4*)(crow_p + q * 8 + 4);
          const int d = q * 8;
          u32x4 o;
          o[0] = cvtpk(a0[0] * rs2 * gk[d], a0[1] * rs2 * gk[d + 1]);
          o[1] = cvtpk(a0[2] * rs2 * gk[d + 2], a0[3] * rs2 * gk[d + 3]);
          o[2] = cvtpk(a1[0] * rs2 * gk[d + 4], a1[1] * rs2 * gk[d + 5]);
          o[3] = cvtpk(a1[2] * rs2 * gk[d + 6], a1[3] * rs2 * gk[d + 7]);
          *(u32x4*)(kdst + d) = o;
        }
#pragma unroll
        for (int q = 0; q < 16; ++q) {
          const float a1 = x1[q] * rs * gk[64 + q], a2 = x2[q] * rs * gk[80 + q];
          const float c = cosT[t * 16 + q], s = sinT[t * 16 + q];
          x1[q] = a1 * c - a2 * s; x2[q] = a2 * c + a1 * s;
        }
#pragma unroll
        for (int q = 0; q < 2; ++q) {
          u32x4 w1, w2;
#pragma unroll
          for (int e = 0; e < 4; ++e) { w1[e] = cvtpk(x1[q * 8 + 2 * e], x1[q * 8 + 2 * e + 1]); w2[e] = cvtpk(x2[q * 8 + 2 * e], x2[q * 8 + 2 * e + 1]); }
          *(u32x4*)(kdst + 64 + q * 8) = w1;
          *(u32x4*)(kdst + 80 + q * 8) = w2;
        }
      }
      __syncthreads();
      acc_to_cs<4>(acc, Cs, 1);
      __syncthreads();
      store_vt(Cs, rowss, VT, b * 16 + 2 * hp, 1, s0);
    }
  }
}

template <bool MLA>
DI void attn_item(const Params& P, int l, int bh, int qb, u16* sm) {
  constexpr int DK = MLA ? 96 : 64, KSTR = DK + 8, NKS = DK / 16;
  constexpr int KROWB = DK * 2, KBYTES = 64 * KROWB, STG = KBYTES + 8192, NI = STG / 4096;
  constexpr int QOFF = MLA ? 2 * STG : 3 * STG;
  static_assert(QOFF + 128 * KSTR * 2 <= SMEM_MAIN, "attention LDS map");
  unsigned char* smb = (unsigned char*)sm;
  u16* Qs = (u16*)(smb + QOFF);
  const int tid = otid(), lane = tid & 63, w = tid >> 6, r = lane & 31, h = lane >> 5;
  const int b = bh >> 4, hh = bh & 15;
  const int tq0 = b * S_ + qb * 128;
  const u16* Kg = (const u16*)(P.ws + WS_KBUF) + (size_t)bh * S_ * DK;
  const u16* Vg = (const u16*)(P.ws + WS_VT) + (size_t)bh * 64 * S_;
  u16* GATE = (u16*)(P.ws + WS_GATE);
  const int nkt = 2 * qb + 2;
  const unsigned lds0 = (unsigned)(__UINTPTR_TYPE__)(LAS unsigned char*)smb;
  const u16* gp[NI]; int adv[NI]; unsigned pdst[NI];
#pragma unroll
  for (int j = 0; j < NI; ++j) {
    const int q = __builtin_amdgcn_readfirstlane(w * NI + j);
    pdst[j] = (unsigned)q * 1024u;
    if (q < KBYTES / 1024) {
      const int sl = q * 64 + lane, key = sl / (DK / 8), pc = sl - key * (DK / 8), c = pc ^ ((key >> 2) & 3);
      gp[j] = Kg + key * DK + c * 8; adv[j] = 64 * DK;
    } else {
      const int sl = (q - KBYTES / 1024) * 64 + lane, d = sl >> 3, pc = sl & 7, c = pc ^ ((d >> 1) & 7);
      gp[j] = Vg + d * 64 + c * 8; adv[j] = 64 * 64;
    }
  }
#define KV_ISSUE(kt, st) do { \
    _Pragma("unroll") for (int j = 0; j < NI; ++j) glds16(gp[j] + (size_t)(kt) * adv[j], lds0 + (unsigned)(st) * STG + pdst[j]); } while (0)

  __syncthreads();
  KV_ISSUE(MLA ? 0 : nkt - 1, 0);
  KV_ISSUE(MLA ? 1 : nkt - 2, 1);
  if constexpr (MLA) {
    const u16* QRAW = (const u16*)(P.ws + WS_XA);
    const float* gq = P.mla_q_head_g + l * 96;
    const float* cosT = (const float*)(P.ws + WS_COS); const float* sinT = (const float*)(P.ws + WS_SIN);
    const int m = tid >> 1, hf = tid & 1, t = tq0 + m;
    const u16* src = QRAW + (size_t)t * LDQR + hh * 96 + hf * 48;
    float q[48];
#pragma unroll
    for (int c = 0; c < 6; ++c) {
      const u32x4 u = *(const u32x4*)(src + c * 8);
#pragma unroll
      for (int e = 0; e < 4; ++e) { q[c * 8 + 2 * e] = bflo(u[e]); q[c * 8 + 2 * e + 1] = bfhi(u[e]); }
    }
    float ssq = 0.f;
#pragma unroll
    for (int d = 0; d < 48; ++d) ssq += q[d] * q[d];
    ssq += __shfl_xor(ssq, 1);
    const float rs = frsq(ssq * (1.f / 96.f) + EPS) * (0.10206207261596575f * LOG2E);
#pragma unroll
    for (int d = 0; d < 48; ++d) q[d] = q[d] * rs * gq[hf * 48 + d];
    if (hf) {
#pragma unroll
      for (int i4 = 0; i4 < 4; ++i4) {
        const f32x4 c4 = *(const f32x4*)(cosT + t * 16 + i4 * 4), s4 = *(const f32x4*)(sinT + t * 16 + i4 * 4);
#pragma unroll
        for (int e = 0; e < 4; ++e) {
          const int i2 = i4 * 4 + e;
          const float a1 = q[16 + i2], a2 = q[32 + i2];
          q[16 + i2] = a1 * c4[e] - a2 * s4[e]; q[32 + i2] = a2 * c4[e] + a1 * s4[e];
        }
      }
    }
    u16* qd = Qs + m * KSTR + hf * 48;
#pragma unroll
    for (int c = 0; c < 6; ++c) {
      u32x4 o;
#pragma unroll
      for (int e = 0; e < 4; ++e) o[e] = cvtpk(q[c * 8 + 2 * e], q[c * 8 + 2 * e + 1]);
      *(u32x4*)(qd + c * 8) = o;
    }
  } else {
    const u16* QSB = (const u16*)(P.ws + WS_XA);
#pragma unroll
    for (int j = 0; j < 4; ++j) {
      const int c = tid + 256 * j, row = c >> 3, c8 = c & 7;
      const u32x4 u = *(const u32x4*)(QSB + (size_t)(tq0 + row) * LDX + hh * 64 + c8 * 8);
      *(u32x4*)(Qs + row * KSTR + c8 * 8) = u;
    }
  }
  __syncthreads();
  bf16x8 qf[NKS];
#pragma unroll
  for (int s = 0; s < NKS; ++s) qf[s] = *(const bf16x8*)(Qs + (w * 32 + r) * KSTR + 16 * s + 8 * h);

  f32x16 O[2];
#pragma unroll
  for (int i = 0; i < 16; ++i) { O[0][i] = 0.f; O[1][i] = 0.f; }
  float m_run = -1e30f, lsum = 0.f, carry = 1.f;
  const f32x16 zero16 = {0.f, 0.f, 0.f, 0.f, 0.f, 0.f, 0.f, 0.f, 0.f, 0.f, 0.f, 0.f, 0.f, 0.f, 0.f, 0.f};
  const int q0 = qb * 128 + w * 32;

  int st_cur = 0, st_nxt = 2;
#pragma unroll 2
  for (int it = 0; it < nkt; ++it) {
    const int kt = MLA ? it : nkt - 1 - it;
    asm volatile("s_waitcnt vmcnt(%0) lgkmcnt(0)" :: "n"(NI) : "memory");
    __builtin_amdgcn_s_barrier();
    { const int itn = min(it + 2, nkt - 1); KV_ISSUE(MLA ? itn : nkt - 1 - itn, st_nxt); }
    const unsigned char* stg = smb + st_cur * STG;
    st_cur = (st_cur == 2) ? 0 : st_cur + 1; st_nxt = (st_nxt == 2) ? 0 : st_nxt + 1;
    const int kbase = kt * 64;
    const bool active = MLA ? (kbase <= q0 + 31) : (kbase <= q0 + 30);
    if (active) {
      const unsigned char* Kc = stg + r * KROWB;
      const unsigned char* Vc = stg + KBYTES + r * 128;
      const int swk = (r >> 2) & 3, swv = (r >> 1) & 7;
      f32x16 st[2];
      {
        bf16x8 kf[NKS][2];
#pragma unroll
        for (int s = 0; s < NKS; ++s) {
          const int ko = ((2 * s + h) ^ swk) * 16;
          kf[s][0] = *(const bf16x8*)(Kc + ko);
          kf[s][1] = *(const bf16x8*)(Kc + 32 * KROWB + ko);
        }
        __builtin_amdgcn_sched_barrier(0);
        __builtin_amdgcn_s_setprio(1);
#pragma unroll
        for (int s = 0; s < NKS; ++s) {
          st[0] = mfma32(kf[s][0], qf[s], s == 0 ? zero16 : st[0]);
          st[1] = mfma32(kf[s][1], qf[s], s == 0 ? zero16 : st[1]);
        }
        __builtin_amdgcn_s_setprio(0);
      }
      bf16x8 pf[2][2];
      if constexpr (MLA) {
        if (kbase + 63 > q0) {
#pragma unroll
          for (int kb = 0; kb < 2; ++kb)
#pragma unroll
            for (int i = 0; i < 16; ++i) { const int key = kbase + kb * 32 + crow(i, h); if (key > q0 + r) st[kb][i] = -1e30f; }
        }
        float mx = st[0][0];
#pragma unroll
        for (int i = 1; i < 16; ++i) mx = fmaxf(mx, st[0][i]);
#pragma unroll
        for (int i = 0; i < 16; ++i) mx = fmaxf(mx, st[1][i]);
        mx = pair_max(mx);
        const float mnew = fmaxf(m_run, mx);
        const float alpha = fexp2(m_run - mnew);
        m_run = mnew;
        f32x2_t ps2 = {0.f, 0.f};
        const f32x2_t mn2 = {mnew, mnew};
#pragma unroll
        for (int kb = 0; kb < 2; ++kb)
#pragma unroll
          for (int i = 0; i < 16; i += 2) {
            f32x2_t d2 = {st[kb][i], st[kb][i + 1]}; d2 -= mn2;
            f32x2_t p2 = {fexp2(d2[0]), fexp2(d2[1])};
            st[kb][i] = p2[0]; st[kb][i + 1] = p2[1]; ps2 += p2;
          }
        const float psum = ps2[0] + ps2[1];
        if (__builtin_amdgcn_ballot_w64(alpha != 1.f) != 0ull) {
          lsum *= alpha;
#pragma unroll
          for (int i = 0; i < 16; ++i) { O[0][i] *= alpha; O[1][i] *= alpha; }
        }
        lsum += psum;
      } else {
        const bool msk = (kbase + 63 >= q0);
        f32x16 L[2];
#define SB_ELEMS(MASKED) do { \
          _Pragma("unroll") for (int kb = 0; kb < 2; ++kb) _Pragma("unroll") for (int i = 0; i < 16; i += 2) { \
            const f32x2_t u2 = {fexp2(__builtin_amdgcn_fmed3f(st[kb][i], -1e30f, 80.f)), fexp2(__builtin_amdgcn_fmed3f(st[kb][i + 1], -1e30f, 80.f))}; \
            const f32x2_t w2 = u2 + 1.f; \
            f32x2_t om2 = {frcp(w2[0]), frcp(w2[1])}; \
            f32x2_t be2 = u2 * om2; \
            if (MASKED) { const int key = kbase + kb * 32 + crow(i, h); const bool v0 = key < q0 + r, v1 = key + 1 < q0 + r; \
              om2[0] = v0 ? om2[0] : 1.f; om2[1] = v1 ? om2[1] : 1.f; be2[0] = v0 ? be2[0] : 0.f; be2[1] = v1 ? be2[1] : 0.f; } \
            L[kb][i] = om2[0]; L[kb][i + 1] = om2[1]; st[kb][i] = be2[0]; st[kb][i + 1] = be2[1]; } } while (0)
        if (msk) SB_ELEMS(true); else SB_ELEMS(false);
#undef SB_ELEMS
        float Rr[2][4], Rp[2][4], E[2][4];
#pragma unroll
        for (int kb = 0; kb < 2; ++kb)
#pragma unroll
          for (int g = 0; g < 4; ++g) { Rr[kb][g] = (L[kb][4 * g] * L[kb][4 * g + 1]) * (L[kb][4 * g + 2] * L[kb][4 * g + 3]); Rp[kb][g] = pair_other(Rr[kb][g], h); }
        float run = 1.f;
#pragma unroll
        for (int idx = 7; idx >= 0; --idx) { const int kb = idx >> 2, g = idx & 3; E[kb][g] = run; run *= Rr[kb][g] * Rp[kb][g]; }
#pragma unroll
        for (int kb = 0; kb < 2; ++kb)
#pragma unroll
          for (int g = 0; g < 4; ++g) {
            const float t3 = carry * E[kb][g] * (h == 0 ? Rp[kb][g] : 1.f);
            const float t2 = t3 * L[kb][4 * g + 3];
            const float t1 = t2 * L[kb][4 * g + 2];
            const float t0 = t1 * L[kb][4 * g + 1];
            { f32x2_t a = {st[kb][4 * g + 0], st[kb][4 * g + 1]}; const f32x2_t tt = {t0, t1}; a *= tt; st[kb][4 * g + 0] = a[0]; st[kb][4 * g + 1] = a[1]; }
            { f32x2_t a = {st[kb][4 * g + 2], st[kb][4 * g + 3]}; const f32x2_t tt = {t2, t3}; a *= tt; st[kb][4 * g + 2] = a[0]; st[kb][4 * g + 3] = a[1]; }
          }
        carry *= run;
      }
#pragma unroll
      for (int kb = 0; kb < 2; ++kb)
#pragma unroll
        for (int s2 = 0; s2 < 2; ++s2) {
          u32x4 pk;
#pragma unroll
          for (int e = 0; e < 4; ++e) pk[e] = cvtpk(st[kb][8 * s2 + 2 * e], st[kb][8 * s2 + 2 * e + 1]);
          pf[kb][s2] = __builtin_bit_cast(bf16x8, pk);
        }
      {
        u32x4 vf[2][2][2];
#pragma unroll
        for (int db = 0; db < 2; ++db)
#pragma unroll
          for (int kb = 0; kb < 2; ++kb)
#pragma unroll
            for (int s2 = 0; s2 < 2; ++s2) {
              vf[db][kb][s2] = *(const u32x4*)(Vc + db * 32 * 128 + ((kb * 4 + s2 * 2 + h) ^ swv) * 16);
            }
        __builtin_amdgcn_sched_barrier(0);
        __builtin_amdgcn_s_setprio(1);
#pragma unroll
        for (int db = 0; db < 2; ++db)
#pragma unroll
          for (int kb = 0; kb < 2; ++kb)
#pragma unroll
            for (int s2 = 0; s2 < 2; ++s2) O[db] = mfma32(__builtin_bit_cast(bf16x8, vf[db][kb][s2]), pf[kb][s2], O[db]);
        __builtin_amdgcn_s_setprio(0);
      }
    }
  }
#undef KV_ISSUE
  asm volatile("s_waitcnt vmcnt(0)" ::: "memory");
  __syncthreads();
  float inv = 1.f;
  if constexpr (MLA) { const float lt = pair_sum(lsum); inv = frcp(lt); }
  float* Ob = (float*)(Qs + w * 32 * KSTR);
#pragma unroll
  for (int db = 0; db < 2; ++db) {
    __builtin_amdgcn_s_waitcnt(0xc07f);
    __builtin_amdgcn_wave_barrier();
#pragma unroll
    for (int i = 0; i < 16; ++i) Ob[r * 33 + crow(i, h)] = O[db][i] * inv;
    __builtin_amdgcn_s_waitcnt(0xc07f);
    __builtin_amdgcn_wave_barrier();
    const int qq = lane >> 1, dh = (lane & 1) * 16;
    u16* gp = GATE + tix(tq0 + w * 32 + qq, hh * 64 + db * 32 + dh);
    const u32x4 g0 = *(const u32x4*)gp, g1 = *(const u32x4*)(gp + 8);
    float ov[16];
#pragma unroll
    for (int e = 0; e < 16; ++e) ov[e] = Ob[qq * 33 + dh + e];
    u32x4 o0, o1;
#pragma unroll
    for (int e = 0; e < 4; ++e) {
      o0[e] = cvtpk(silu_mul(ov[2 * e], bflo(g0[e])), silu_mul(ov[2 * e + 1], bfhi(g0[e])));
      o1[e] = cvtpk(silu_mul(ov[8 + 2 * e], bflo(g1[e])), silu_mul(ov[8 + 2 * e + 1], bfhi(g1[e])));
    }
    *(u32x4*)gp = o0; *(u32x4*)(gp + 8) = o1;
  }
}

template <bool MLA>
DI void phase_attn(const Params& P, int l, unsigned char* smem, unsigned xcc, int ph) {
  volatile LAS unsigned* stw = (volatile LAS unsigned*)(smem + SMEM_ST);
  unsigned* ctrs = (unsigned*)(P.ws + WS_BAR) + 3520 + ph * 128;
  for (int qx = 0; qx < 8; ++qx) {
    const int xq = (int)((xcc + (unsigned)qx) & 7u);
    for (;;) {
      TSTART(4)
      if (threadIdx.x == 0) stw[3] = atomicAdd(ctrs + xq * 16, 1u);
      __syncthreads();
      const int it = (int)stw[3];
      __syncthreads();
      if (it >= 256) break;
      attn_item<MLA>(P, l, xq * 16 + (it & 15), 15 - (it >> 4), (u16*)smem);
      TSTOP(4)
    }
  }
}

DI void phase_out(const Params& P, const u16* Wout, const float* xres, int li, unsigned char* smem, int v, int G) {
  u16* sm = (u16*)smem; float* rowss = (float*)(smem + SMEM_ROWSS); float* Cs = (float*)smem;
  const u16* OG = (const u16*)(P.ws + WS_GATE); u16* XAB = (u16*)(P.ws + WS_XA);
  {
    const float* pin = P.p + (size_t)li * T_ * 256; u16* PB = (u16*)(P.ws + WS_PB);
    const int tid = otid(), GS = G * NTHR;
    for (int e0 = v * NTHR + tid; e0 < T_ * 256 / 4; e0 += 8 * GS) {
      f32x4 xv[8];
#pragma unroll
      for (int q = 0; q < 8; ++q) { const int e = e0 + q * GS; if (e < T_ * 256 / 4) xv[q] = __builtin_nontemporal_load((const f32x4*)(pin + (size_t)e * 4)); }
#pragma unroll
      for (int q = 0; q < 8; ++q) { const int e = e0 + q * GS; if (e < T_ * 256 / 4) *(u32x2*)(PB + tixp(e >> 6, (e & 63) * 4)) = pack4(xv[q], 1.f); }
    }
  }
  for (int tile = v; tile < 128 * 4; tile += G) {
    const int mt = tile >> 2, nt = tile & 3, t0 = mt * 128;
    f32x16 acc[2][4]; acc_zero<4>(acc);
    gemm_main<4, false, false>(OG + tix(t0, 0), 0, Wout + (size_t)nt * 256 * KP1024, KP1024, 1024, acc, sm, rowss, 0.f);
    EPI_TILE_RES(4, acc, xres, t0, nt * 256, { const size_t o = (size_t)(t0 + m) * 1024 + nt * 256 + gc;
                       const f32x4 xn = res + val;
                       *(f32x4*)(P.out + o) = xn; *(u32x2*)(XAB + tix(t0 + m, nt * 256 + gc)) = pack4(xn, 1.f); });
  }
}

DI void phase_ple(const Params& P, int li, unsigned char* smem, int v, int G) {
  u16* sm = (u16*)smem; float* rowss = (float*)(smem + SMEM_ROWSS); float* Cs = (float*)smem;
  const u16* XAB = (const u16*)(P.ws + WS_XA); u16* XB = (u16*)(P.ws + WS_XB);
  const u16* Wg = (const u16*)(P.ws + WS_W) + W_PLE + li * W_PLE_SZ; const u16* Wp = Wg + (size_t)1024 * KP1024;
  const u16* PB = (const u16*)(P.ws + WS_PB);
  for (int tile = v; tile < 128 * 8; tile += G) {
    const int mt = tile >> 3, nt = tile & 7, t0 = mt * 128;
    f32x16 acc[2][2]; acc_zero<2>(acc);
    gemm_main<2, false, false>(XAB + tix(t0, 0), 0, Wg + (size_t)nt * 128 * KP1024, KP1024, 1024, acc, sm, rowss, 0.f);
#pragma unroll
    for (int a = 0; a < 2; ++a)
#pragma unroll
      for (int b = 0; b < 2; ++b)
#pragma unroll
        for (int i = 0; i < 16; ++i) acc[a][b][i] = frcp(1.f + fexp2(-acc[a][b][i] * LOG2E));
    {
      f32x16 acu[2][2]; acc_zero<2>(acu);
      gemm_main<2, false, false>(PB + tixp(t0, 0), 0, Wp + (size_t)nt * 128 * KP256, KP256, 256, acu, sm, rowss, 0.f);
#pragma unroll
      for (int a = 0; a < 2; ++a)
#pragma unroll
        for (int b = 0; b < 2; ++b) acc[a][b] *= acu[a][b];
    }
    EPI_TILE_RES(2, acc, P.out, t0, nt * 128, { const size_t o = (size_t)(t0 + m) * 1024 + nt * 128 + gc;
                       f32x4 xn = res + val;
                       if (PROBE_SEL != 0 && li == 3) { const float tus = *(const float*)(P.ws + WS_BAR + 32); xn *= (1.f + ((m & 1) ? 3e-6f : -3e-6f) * tus); }
                       *(f32x4*)(P.out + o) = xn; if (li != 3) *(u32x2*)(XB + tix(t0 + m, nt * 128 + gc)) = pack4(xn, 1.f); });
  }
}

DI void phase_sb_in(const Params& P, int j, unsigned char* smem, int v, int G) {
  u16* sm = (u16*)smem; float* rowss = (float*)(smem + SMEM_ROWSS); float* Cs = (float*)smem;
  const u16* Wt = (const u16*)(P.ws + WS_W) + (j == 0 ? W_SB0 : W_SB1);
  const int NT = (j == 0) ? 16 : 8;
  const u16* XB = (const u16*)(P.ws + WS_XB);
  u16* QSB = (u16*)(P.ws + WS_XA); u16* GATE = (u16*)(P.ws + WS_GATE);
  u16* KSH = (u16*)(P.ws + WS_KBUF); u16* VT = (u16*)(P.ws + WS_VT);
  for (int tile = v; tile < 128 * NT; tile += G) {
    const int mt = tile / NT, nt = tile - mt * NT, t0 = mt * 128;
    f32x16 acc[2][4]; acc_zero<4>(acc);
    gemm_main<4, false, true>(XB + tix(t0, 0), 0, Wt + (size_t)nt * 256 * KP1024, KP1024, 1024, acc, sm, rowss, 1.f / 1024.f);
    const int b = t0 >> 11, s0 = t0 & 2047;
    if (nt < 4) {
      EPI_TILE(4, acc, { *(u32x2*)(QSB + (size_t)(t0 + m) * LDX + nt * 256 + gc) = pack4(val, rowss[m]); });
    } else if (nt < 8) {
      EPI_TILE(4, acc, { *(u32x2*)(GATE + tix(t0 + m, (nt - 4) * 256 + gc)) = pack4(val, rowss[m]); });
    } else if (nt < 12) {
      EPI_TILE(4, acc, { const int c = (nt - 8) * 256 + gc;
                         *(u32x2*)(KSH + ((size_t)(b * 16 + (c >> 6)) * S_ + s0 + m) * 64 + (c & 63)) = pack4(val, rowss[m]); });
    } else {
#pragma unroll
      for (int p = 0; p < 2; ++p) {
        if (p) __syncthreads();
        acc_to_cs<4>(acc, Cs, p);
        __syncthreads();
        store_vt(Cs, rowss, VT, b * 16 + (nt - 12) * 4 + p, 2, s0);
      }
    }
  }
}

__global__ void __launch_bounds__(NTHR, 2) yoco_fwd(Params P) {
  extern __shared__ __attribute__((aligned(16))) unsigned char smem[];
  const int G = gridDim.x, bx = blockIdx.x;
  const int v = (G % 8 == 0) ? (bx % 8) * (G / 8) + bx / 8 : bx;
  volatile LAS unsigned* st = (volatile LAS unsigned*)(smem + SMEM_ST);
  if (threadIdx.x < 4) st[threadIdx.x] = 0u;
  __syncthreads();
  XcdBarrier bar = xcd_barrier_post((unsigned*)(P.ws + WS_BAR), st);
  TSTART(7)

  { TSTART(5)
  phase_prep(P, smem, v, G);
  prep_jobs(P, smem, v, G, 0, 3);
  TSTOP(5) }
  { TSTART(6)
  if (P.ws == nullptr) cg::this_grid().sync();
  xcd_barrier(bar);
  TSTOP(6) }

  const u16* W = (const u16*)(P.ws + WS_W);
#pragma unroll 1
  for (int l = 0; l < 2; ++l) {
    const float* xcur = (l == 0) ? P.x : P.out;
    { TSTART(2) phase_mla_in(P, l, smem, v, G); TSTOP(2) }
    xcd_barrier(bar);
    { TSTART(2) phase_mla_qkv(P, l, smem, v, G); TSTOP(2) }
    xcd_barrier(bar);
    if (l == 0) { prep_jobs(P, smem, v, G, 3, 8); prep_jobs(P, smem, v, G, 13, 15); }
    else        { prep_jobs(P, smem, v, G, 8, 10); prep_jobs(P, smem, v, G, 15, 17); }
    phase_attn<true>(P, l, smem, bar.x, l);
    { TSTART(8) xcd_barrier(bar); TSTOP(8) }
    { TSTART(2) phase_out(P, W + l * W_MLA_SZ + W_MLA_OUT, xcur, l, smem, v, G); TSTOP(2) }
    xcd_barrier(bar);
    { TSTART(2) phase_ple(P, l, smem, v, G); TSTOP(2) }
    xcd_barrier(bar);
  }
#pragma unroll 1
  for (int j = 0; j < 2; ++j) {
    { TSTART(2) phase_sb_in(P, j, smem, v, G); TSTOP(2) }
    xcd_barrier(bar);
    if (j == 0) { prep_jobs(P, smem, v, G, 10, 12); prep_jobs(P, smem, v, G, 17, 19); }
    else        { prep_jobs(P, smem, v, G, 12, 13); prep_jobs(P, smem, v, G, 19, 21); }
    phase_attn<false>(P, j, smem, bar.x, 2 + j);
    { TSTART(8) xcd_barrier(bar); TSTOP(8) }
    { TSTART(2) phase_out(P, W + (j == 0 ? W_SB0_OUT : W_SB1_OUT), P.out, 2 + j, smem, v, G); TSTOP(2) }
    xcd_barrier(bar);
    if (PROBE_SEL != 0 && j == 1) {
      TSTOP(7)
      if (blockIdx.x == 0 && threadIdx.x == 0) { const float tus = (float)st[2] * 0.01f; *(volatile float*)(P.ws + WS_BAR + 32) = tus; }
      xcd_barrier(bar);
    }
    phase_ple(P, 2 + j, smem, v, G);
    if (j == 0) xcd_barrier(bar);
  }
}

extern "C" void kernel_launch(void* const* d_in, const int* in_sizes, int n_in, void* d_out, int out_size,
                              void* d_ws, size_t ws_size, hipStream_t stream) {
  static int grid_blocks = 0;
  if (!grid_blocks) {
    int dev = 0, cus = 0, per_cu = 0;
    hipGetDevice(&dev);
    hipDeviceGetAttribute(&cus, hipDeviceAttributeMultiprocessorCount, dev);
    hipFuncSetAttribute((const void*)yoco_fwd, hipFuncAttributeMaxDynamicSharedMemorySize, SMEM_BYTES);
    hipOccupancyMaxActiveBlocksPerMultiprocessor(&per_cu, (const void*)yoco_fwd, NTHR, SMEM_BYTES);
    if (per_cu > 2) per_cu = 2;
    if (per_cu < 1) per_cu = 1;
    grid_blocks = cus * per_cu;
    if (ws_size < WS_END) fprintf(stderr, "kernel_launch: workspace too small: %zu < %zu\n", ws_size, (size_t)WS_END);
  }
  Params P{};
  P.x = (const float*)d_in[0]; P.p = (const float*)d_in[1]; P.pos = (const int*)d_in[2];
  P.mla_ln_g = (const float*)d_in[3]; P.mla_w_in = (const float*)d_in[4]; P.mla_q_norm_g = (const float*)d_in[5];
  P.mla_kv_norm_g = (const float*)d_in[6]; P.mla_w_q_up = (const float*)d_in[7]; P.mla_w_kv_up = (const float*)d_in[8];
  P.mla_q_head_g = (const float*)d_in[9]; P.mla_k_head_g = (const float*)d_in[10]; P.mla_w_out = (const float*)d_in[11];
  P.kv_ln_g = (const float*)d_in[12]; P.w_kv_shared = (const float*)d_in[13]; P.sb_ln_g = (const float*)d_in[14];
  P.sb_w_in = (const float*)d_in[15]; P.sb_w_out = (const float*)d_in[16]; P.ple_w_proj = (const float*)d_in[17];
  P.ple_w_gate = (const float*)d_in[18];
  P.out = (float*)d_out; P.ws = (unsigned char*)d_ws;
  hipMemsetAsync((char*)d_ws + WS_BAR, 0, 16384, stream);
  void* args[] = {&P};
  hipError_t e = hipLaunchCooperativeKernel((const void*)yoco_fwd, dim3(grid_blocks), dim3(NTHR), args, SMEM_BYTES, stream);
  if (e != hipSuccess) fprintf(stderr, "cooperative launch failed: %s (grid %d)\n", hipGetErrorString(e), grid_blocks);
}
```
